# Optimizing an MI355X kernel written in HIP

```python
import math
import jax, jax.numpy as jnp
from jax import lax
import numpy as np

D_MODEL = 2048
BATCH = 8
SEQ = 2048
DEPTH = 1

Q_BLOCK = 128
ROPE_THETA = 10000.0
NORM_EPS = 1e-6

MLA_HEADS = 8
MLA_NOPE_DIM = 128
MLA_ROPE_DIM = 64
MLA_V_DIM = 128
MLA_Q_LORA = 512
MLA_KV_LORA = 256
MLA_OUT = MLA_HEADS * MLA_V_DIM

DIFF_HEADS = 4
DIFF_HEAD_DIM = 128
DIFF_V_DIM = 2 * DIFF_HEAD_DIM
DIFF_W = DIFF_HEADS * 2 * DIFF_HEAD_DIM
DIFF_OUT = DIFF_HEADS * DIFF_V_DIM

MIX_WIDTH = MLA_OUT + DIFF_OUT

IN_SPLITS = (MLA_Q_LORA, MLA_KV_LORA, MLA_ROPE_DIM, DIFF_W, DIFF_W, DIFF_W)
IN_WIDTH = sum(IN_SPLITS)

MEM_TOKENS = 256
X_HEADS = 4
X_HEAD_DIM = 128
X_WIDTH = X_HEADS * X_HEAD_DIM

FFN_HIDDEN = int(math.ceil(8 * D_MODEL / 3 / 256) * 256)

kernel_name = "hybrid_mla_diffattn_parallel_heads_encoder"


def rms_norm(x, g, eps=NORM_EPS):
    xf = x.astype(jnp.float32)
    y = xf * lax.rsqrt(jnp.mean(xf * xf, axis=-1, keepdims=True) + eps)
    return (y * g.astype(jnp.float32)).astype(x.dtype)


def rope_tables(positions, dim):
    inv_freq = ROPE_THETA ** (-jnp.arange(0, dim, 2, dtype=jnp.float32) / dim)
    ang = positions.astype(jnp.float32)[..., None] * inv_freq
    return jnp.cos(ang), jnp.sin(ang)


def apply_rope(t, cos, sin):
    shp = cos.shape[:2] + (1,) * (t.ndim - 3) + cos.shape[-1:]
    c, s = cos.reshape(shp), sin.reshape(shp)
    half = t.shape[-1] // 2
    t1 = t[..., :half].astype(jnp.float32)
    t2 = t[..., half:].astype(jnp.float32)
    return jnp.concatenate([t1 * c - t2 * s, t1 * s + t2 * c], axis=-1).astype(t.dtype)


def _to_blocks(t):
    b, s = t.shape[:2]
    return jnp.moveaxis(t.reshape((b, s // Q_BLOCK, Q_BLOCK) + t.shape[2:]), 1, 0)


def _from_blocks(t):
    t = jnp.moveaxis(t, 0, 1)
    return t.reshape((t.shape[0], t.shape[1] * t.shape[2]) + t.shape[3:])


def mla_attention(q_nope, q_rope, k_nope, k_rope, v):
    scale = (MLA_NOPE_DIM + MLA_ROPE_DIM) ** -0.5

    def block(qs):
        qn_b, qr_b = qs
        s = (jnp.einsum('bqhd,bkhd->bhqk', qn_b, k_nope)
             + jnp.einsum('bqhr,bkr->bhqk', qr_b, k_rope))
        p = jax.nn.softmax(s.astype(jnp.float32) * scale, axis=-1).astype(v.dtype)
        return jnp.einsum('bhqk,bkhd->bqhd', p, v)

    return _from_blocks(lax.map(block, (_to_blocks(q_nope), _to_blocks(q_rope))))


def diff_attention(q1, q2, k1, k2, v, lam):
    scale = DIFF_HEAD_DIM ** -0.5

    def block(qs):
        q1_b, q2_b = qs
        p1 = jax.nn.softmax(jnp.einsum('bqhd,bkhd->bhqk', q1_b, k1).astype(jnp.float32) * scale, axis=-1)
        p2 = jax.nn.softmax(jnp.einsum('bqhd,bkhd->bhqk', q2_b, k2).astype(jnp.float32) * scale, axis=-1)
        p = (p1 - lam * p2).astype(v.dtype)
        return jnp.einsum('bhqk,bkhe->bqhe', p, v)

    return _from_blocks(lax.map(block, (_to_blocks(q1), _to_blocks(q2))))


def setup_inputs(seed: int = 0) -> dict:
    key = jax.random.key(seed)
    ks = iter(jax.random.split(key, 40))

    def dense(shape):
        return jax.random.normal(next(ks), shape, jnp.float32) * (shape[-2] ** -0.5)

    def gain(n):
        return 1.0 + 0.02 * jax.random.normal(next(ks), (DEPTH, n), jnp.float32)

    x = jax.random.normal(next(ks), (BATCH, SEQ, D_MODEL), jnp.float32)
    mem = jax.random.normal(next(ks), (BATCH, MEM_TOKENS, D_MODEL), jnp.float32)
    offsets = jax.random.randint(next(ks), (BATCH, 1), 0, 1024, dtype=jnp.int32)
    positions = jnp.arange(SEQ, dtype=jnp.int32)[None, :] + offsets

    return {
        "x": x,
        "mem": mem,
        "positions": positions,
        "g_mix": gain(D_MODEL),
        "w_in": dense((DEPTH, D_MODEL, IN_WIDTH)),
        "g_q_lat": gain(MLA_Q_LORA),
        "w_uq": dense((DEPTH, MLA_Q_LORA, MLA_HEADS * (MLA_NOPE_DIM + MLA_ROPE_DIM))),
        "g_kv_lat": gain(MLA_KV_LORA),
        "w_ukv": dense((DEPTH, MLA_KV_LORA, MLA_HEADS * (MLA_NOPE_DIM + MLA_V_DIM))),
        "lambda_q1": 0.1 * jax.random.normal(next(ks), (DEPTH, DIFF_HEAD_DIM), jnp.float32),
        "lambda_k1": 0.1 * jax.random.normal(next(ks), (DEPTH, DIFF_HEAD_DIM), jnp.float32),
        "lambda_q2": 0.1 * jax.random.normal(next(ks), (DEPTH, DIFF_HEAD_DIM), jnp.float32),
        "lambda_k2": 0.1 * jax.random.normal(next(ks), (DEPTH, DIFF_HEAD_DIM), jnp.float32),
        "g_diff_sub": gain(DIFF_V_DIM),
        "w_out": dense((DEPTH, MIX_WIDTH, D_MODEL)),
        "g_xattn": gain(D_MODEL),
        "g_mem": gain(D_MODEL),
        "w_xq": dense((DEPTH, D_MODEL, X_WIDTH)),
        "w_xk": dense((DEPTH, D_MODEL, X_WIDTH)),
        "w_xv": dense((DEPTH, D_MODEL, X_WIDTH)),
        "w_xo": dense((DEPTH, X_WIDTH, D_MODEL)),
        "g_ffn": gain(D_MODEL),
        "w_gate": dense((DEPTH, D_MODEL, FFN_HIDDEN)),
        "w_up": dense((DEPTH, D_MODEL, FFN_HIDDEN)),
        "w_down": dense((DEPTH, FFN_HIDDEN, D_MODEL)),
        "g_final": 1.0 + 0.02 * jax.random.normal(next(ks), (D_MODEL,), jnp.float32),
    }


def reference(x, mem, positions, g_mix, w_in, g_q_lat, w_uq, g_kv_lat, w_ukv,
              lambda_q1, lambda_k1, lambda_q2, lambda_k2, g_diff_sub, w_out,
              g_xattn, g_mem, w_xq, w_xk, w_xv, w_xo,
              g_ffn, w_gate, w_up, w_down, g_final):
    b, s, _ = x.shape
    m_len = mem.shape[1]
    cos_r, sin_r = rope_tables(positions, MLA_ROPE_DIM)
    cos_d, sin_d = rope_tables(positions, DIFF_HEAD_DIM)
    split_pts = [int(v) for v in np.cumsum(IN_SPLITS)[:-1]]

    for layer in range(DEPTH):
        h = rms_norm(x, g_mix[layer])
        proj = h @ w_in[layer]
        c_q, c_kv, k_rope, dq, dk, dv = jnp.split(proj, split_pts, axis=-1)

        q = (rms_norm(c_q, g_q_lat[layer]) @ w_uq[layer]).reshape(b, s, MLA_HEADS, MLA_NOPE_DIM + MLA_ROPE_DIM)
        q_nope = q[..., :MLA_NOPE_DIM]
        q_rope = apply_rope(q[..., MLA_NOPE_DIM:], cos_r, sin_r)
        kv = (rms_norm(c_kv, g_kv_lat[layer]) @ w_ukv[layer]).reshape(b, s, MLA_HEADS, MLA_NOPE_DIM + MLA_V_DIM)
        k_nope, v_mla = kv[..., :MLA_NOPE_DIM], kv[..., MLA_NOPE_DIM:]
        k_rope = apply_rope(k_rope, cos_r, sin_r)
        out_mla = mla_attention(q_nope, q_rope, k_nope, k_rope, v_mla).reshape(b, s, MLA_OUT)

        dq = apply_rope(dq.reshape(b, s, DIFF_HEADS, 2, DIFF_HEAD_DIM), cos_d, sin_d)
        dk = apply_rope(dk.reshape(b, s, DIFF_HEADS, 2, DIFF_HEAD_DIM), cos_d, sin_d)
        dv = dv.reshape(b, s, DIFF_HEADS, DIFF_V_DIM)
        lambda_init = 0.8 - 0.6 * math.exp(-0.3 * layer)
        lam = (jnp.exp(jnp.sum(lambda_q1[layer].astype(jnp.float32) * lambda_k1[layer].astype(jnp.float32)))
               - jnp.exp(jnp.sum(lambda_q2[layer].astype(jnp.float32) * lambda_k2[layer].astype(jnp.float32)))
               + lambda_init)
        o_diff = diff_attention(dq[..., 0, :], dq[..., 1, :], dk[..., 0, :], dk[..., 1, :], dv, lam)
        o_diff = rms_norm(o_diff, g_diff_sub[layer], eps=1e-5) * (1.0 - lambda_init)
        out_diff = o_diff.reshape(b, s, DIFF_OUT)

        x = x + jnp.concatenate([out_mla, out_diff], axis=-1) @ w_out[layer]

        hx = rms_norm(x, g_xattn[layer])
        hm = rms_norm(mem, g_mem[layer])
        xq = (hx @ w_xq[layer]).reshape(b, s, X_HEADS, X_HEAD_DIM)
        xk = (hm @ w_xk[layer]).reshape(b, m_len, X_HEADS, X_HEAD_DIM)
        xv = (hm @ w_xv[layer]).reshape(b, m_len, X_HEADS, X_HEAD_DIM)
        sc = jnp.einsum('bqhd,bkhd->bhqk', xq, xk).astype(jnp.float32) * (X_HEAD_DIM ** -0.5)
        p = jax.nn.softmax(sc, axis=-1).astype(xv.dtype)
        xo = jnp.einsum('bhqk,bkhd->bqhd', p, xv).reshape(b, s, X_WIDTH)
        x = x + xo @ w_xo[layer]

        hf = rms_norm(x, g_ffn[layer])
        x = x + (jax.nn.silu(hf @ w_gate[layer]) * (hf @ w_up[layer])) @ w_down[layer]

    return rms_norm(x, g_final)
```

```cpp
#include <hip/hip_runtime.h>
#include <hip/hip_bf16.h>
#include <hip/hip_cooperative_groups.h>
#include <cstdio>
namespace cg = cooperative_groups;

typedef unsigned short bf16_t;
typedef short bf16x8 __attribute__((ext_vector_type(8)));
typedef short s16x4 __attribute__((ext_vector_type(4)));
typedef float f32x4 __attribute__((ext_vector_type(4)));
typedef float f32x16 __attribute__((ext_vector_type(16)));
typedef unsigned u32x4 __attribute__((ext_vector_type(4)));
typedef unsigned u32x2 __attribute__((ext_vector_type(2)));
#define LAS __attribute__((address_space(3)))

constexpr int T = 16384, DM = 2048, SEQ = 2048, MEMT = 256, NB = 8;
constexpr int IN_W = 3904, IN_P = 4096, FFN = 5632;
constexpr float NORM_EPS = 1e-6f;

constexpr size_t MiB = (size_t)1 << 20;
constexpr size_t O_WIN = 0, O_WUQ = 16 * MiB, O_WUKV = O_WUQ + 3 * MiB / 2, O_WOUT = O_WUKV + 1 * MiB, O_WXQ = O_WOUT + 8 * MiB, O_WXKV = O_WXQ + 2 * MiB,
                 O_WXO = O_WXKV + 4 * MiB, O_WGU = O_WXO + 2 * MiB, O_WDN = O_WGU + 44 * MiB, O_COSD = O_WDN + 22 * MiB, O_SIND = O_COSD + 4 * MiB,
                 O_COSR = O_SIND + 4 * MiB, O_SINR = O_COSR + 2 * MiB, O_SS = O_SINR + 2 * MiB, O_A = O_SS + MiB / 2;
constexpr size_t O_H = O_A, O_CQ = O_H + 64 * MiB, O_CKV = O_CQ + 16 * MiB, O_KR = O_CKV + 8 * MiB, O_DQ = O_KR + 2 * MiB, O_DK = O_DQ + 32 * MiB, O_DV = O_DK + 32 * MiB,
                 O_B = O_DV + 32 * MiB, O_HID = O_A, O_SCR = O_H;
constexpr size_t O_HM = O_B, O_QN = O_HM + 8 * MiB, O_KN = O_QN + 32 * MiB, O_QR = O_KN + 32 * MiB, O_VM = O_QR + 16 * MiB, O_ATT = O_VM + 32 * MiB, O_XKV = O_ATT + 64 * MiB,
                 WS_END = O_XKV + 4 * MiB, O_X1B = O_QN, O_X2B = O_ATT, O_XQ = O_QR, O_XO = O_VM;
static_assert(O_HID + (size_t)T * FFN * 2 <= O_B, "hidden fits region A");
constexpr int SS_CQ = 0, SS_CKV = T, SS_X1 = 2 * T, SS_X2 = 3 * T, SS_X3 = 4 * T, SS_LAM = 5 * T;

__device__ const double INVF_D[64] = {1, 0.86596432336006535, 0.74989420933245587, 0.64938163157621132, 0.56234132519034907, 0.48696752516586311, 0.42169650342858223, 0.36517412725483772, 0.31622776601683794, 0.27384196342643613, 0.23713737056616552, 0.20535250264571461, 0.17782794100389229, 0.15399265260594919, 0.1333521432163324, 0.11547819846894582, 0.10000000000000001, 0.086596432336006529, 0.074989420933245579, 0.064938163157621132, 0.056234132519034911, 0.048696752516586311, 0.042169650342858224, 0.036517412725483769, 0.031622776601683791, 0.027384196342643614, 0.023713737056616554, 0.02053525026457146, 0.017782794100389229, 0.015399265260594919, 0.013335214321633241, 0.011547819846894581, 0.01, 0.0086596432336006543, 0.0074989420933245579, 0.006493816315762113, 0.005623413251903491, 0.004869675251658631, 0.0042169650342858229, 0.0036517412725483771, 0.0031622776601683794, 0.0027384196342643613, 0.0023713737056616554, 0.002053525026457146, 0.0017782794100389228, 0.001539926526059492, 0.0013335214321633241, 0.0011547819846894581, 0.001, 0.00086596432336006539, 0.00074989420933245586, 0.00064938163157621134, 0.0005623413251903491, 0.0004869675251658631, 0.00042169650342858224, 0.0003651741272548377, 0.00031622776601683794, 0.00027384196342643611, 0.00023713737056616554, 0.00020535250264571461, 0.00017782794100389227, 0.00015399265260594919, 0.0001333521432163324, 0.00011547819846894582};

struct Params {
  const float* in[26];
  float* out;
  unsigned char* ws;
  int ph_lo, ph_hi;
};
enum { I_X = 0, I_MEM, I_POS, I_GMIX, I_WIN, I_GQLAT, I_WUQ, I_GKVLAT, I_WUKV, I_LQ1, I_LK1, I_LQ2, I_LK2, I_GDIFF, I_WOUT, I_GXATTN, I_GMEM, I_WXQ, I_WXK, I_WXV, I_WXO,
       I_GFFN, I_WGATE, I_WUP, I_WDOWN, I_GFINAL };

__device__ __forceinline__ unsigned cvt_pk_bf16(float lo, float hi) { unsigned r; asm volatile("v_cvt_pk_bf16_f32 %0, %1, %2" : "=v"(r) : "v"(lo), "v"(hi)); return r; }
__device__ __forceinline__ bf16_t f2bf(float f) { return (bf16_t)(cvt_pk_bf16(f, 0.f) & 0xffffu); }

namespace pg8 {
constexpr int BM = 256, BK = 64, HALF = 128, HTB = HALF * BK * 2, STAGE_BYTES = 8 * HTB, NXCD = 8, WGM = 8;
__host__ __device__ __forceinline__ int lds_byte(int r, int c) { const int st = (r >> 4) * 2 + (c >> 5), rr = r & 15, cc = c & 31, ob = rr * 64 + cc * 2; return st * 1024 + (ob ^ (((ob >> 9) & 1) << 5)); }
__host__ __device__ __forceinline__ void stage_rc(int b, int& R, int& C) { const int st = b / 1024, sb = b % 1024, swz = sb ^ (((sb >> 9) & 1) << 5); R = (st >> 1) * 16 + swz / 64; C = (st & 1) * 32 + (swz % 64) / 2; }
__host__ __device__ __forceinline__ int perm32(int rho) { const int n = rho >> 4, i = rho & 15; return 8 * (i >> 2) + 4 * n + (i & 3); }
struct Unit { int pm, pn; };
struct Gemm { const bf16_t* A; const bf16_t* Bt; int M, N, K; };
struct StaticOrder {
  int nM, nN, nwg, G, c, panel, only;
  __host__ __device__ void init(int M, int N, int G_, int c_) { nM = M / BM; nN = N / BM; nwg = nM * nN; G = G_; c = c_; panel = 0; only = -1; }
  __host__ __device__ bool next(int i, Unit& u) const {
    if (only >= 0) { if (i != 0) return false; i = only; }
    const long L = (long)i * G + c; if (L >= nwg) return false;
    if (panel) { const int x = c & 7, j = c >> 3; u.pm = x * 8 + i * 4 + (j >> 3); u.pn = j & 7; return true; }
    int wgid = (int)L; { const int q = nwg / NXCD, r = nwg % NXCD, xcd = wgid % NXCD, off = wgid / NXCD; wgid = (xcd < r ? xcd * (q + 1) : r * (q + 1) + (xcd - r) * q) + off; }
    const int nig = WGM * nN, gid = wgid / nig, fm = gid * WGM, gsz = (nM - fm) < WGM ? (nM - fm) : WGM;
    u.pm = fm + ((wgid % nig) % gsz); u.pn = (wgid % nig) / gsz; return true;
  }
};

template <class Epi>
__device__ __forceinline__ void gemm_phase(LAS unsigned char* lds, const Gemm g, const StaticOrder& S, const Epi& E) {
  const int tid = threadIdx.x, wid = __builtin_amdgcn_readfirstlane(tid >> 6), lane = tid & 63, wr = wid >> 2, wc = wid & 3, fr = lane & 15, fq = lane >> 4;
  int K = g.K; asm volatile("" : "+s"(K));
  const int nt = K / BK;
  unsigned voffA[2], voffB[2];
#pragma unroll
  for (int i = 0; i < 2; ++i) { int R, C; stage_rc(tid * 16 + i * 8192, R, C); const int Rb = Epi::PERM ? ((R & ~31) + perm32(R & 31)) : R;
    voffA[i] = (unsigned)(R * K + C) * 2u; voffB[i] = (unsigned)(Rb * K + C) * 2u; }
  const size_t kstep = (size_t)(BK * 2);
  const size_t hstep = (size_t)HALF * K * 2;
  const size_t tstep = 2 * hstep;
  const unsigned ldsw = (unsigned)wid * 1024u;
  const int aoff = lds_byte(wr * 64 + fr, fq * 8), boff = lds_byte(wc * 32 + fr, fq * 8);
#define PG8_SA(b, h) (((b) * 2 + (h)) * HTB)
#define PG8_SB(b, h) ((4 + (b) * 2 + (h)) * HTB)
#define PG8_STAGE(bufoff, gbase, voff) do { _Pragma("unroll") for (int _i = 0; _i < 2; ++_i) \
    __builtin_amdgcn_global_load_lds((const unsigned*)((const char*)(gbase) + (voff)[_i]), (LAS unsigned*)(lds + (bufoff) + ldsw + _i * 8192), 16, 0, 0); } while (0)
#define PG8_LDA(dst, b, h) do { _Pragma("unroll") for (int m = 0; m < 4; ++m) _Pragma("unroll") for (int k = 0; k < 2; ++k) dst[m][k] = *(const LAS bf16x8*)(lds + PG8_SA(b, h) + aoff + m * 2048 + k * 1024); } while (0)
#define PG8_LDB(dst, b, h) do { _Pragma("unroll") for (int n = 0; n < 2; ++n) _Pragma("unroll") for (int k = 0; k < 2; ++k) dst[n][k] = *(const LAS bf16x8*)(lds + PG8_SB(b, h) + boff + n * 2048 + k * 1024); } while (0)
#define PG8_MMA(ai, bj, At, Bt) do { __builtin_amdgcn_s_setprio(1); _Pragma("unroll") for (int m = 0; m < 4; ++m) _Pragma("unroll") for (int n = 0; n < 2; ++n) _Pragma("unroll") for (int k = 0; k < 2; ++k) \
    acc[ai][bj][m][n] = __builtin_amdgcn_mfma_f32_16x16x32_bf16(Bt[n][k], At[m][k], acc[ai][bj][m][n], 0, 0, 0); __builtin_amdgcn_s_setprio(0); } while (0)
#define PG8_WAIT_V(n) asm volatile("s_waitcnt vmcnt(" #n ")" ::: "memory")
#define PG8_WAIT_L(n) asm volatile("s_waitcnt lgkmcnt(" #n ")" ::: "memory")
#define PG8_BAR __builtin_amdgcn_s_barrier()
#define PG8_SCHED __builtin_amdgcn_sched_barrier(0)
  Unit cur, nxt; int ui = 0;
  if (!S.next(0, cur)) return;
  f32x4 acc[2][2][4][2];
#pragma unroll
  for (int a = 0; a < 2; ++a)
#pragma unroll
    for (int b = 0; b < 2; ++b)
#pragma unroll
      for (int m = 0; m < 4; ++m)
#pragma unroll
        for (int n = 0; n < 2; ++n) acc[a][b][m][n] = (f32x4){0.f, 0.f, 0.f, 0.f};
  bf16x8 At[4][2], B0[2][2], B1[2][2];
  const char* cA = (const char*)g.A + (size_t)cur.pm * tstep; const char* cB = (const char*)g.Bt + (size_t)cur.pn * tstep;
  PG8_STAGE(PG8_SB(0, 0), cB, voffB); PG8_STAGE(PG8_SA(0, 0), cA, voffA); PG8_STAGE(PG8_SB(0, 1), cB + hstep, voffB); PG8_STAGE(PG8_SA(0, 1), cA + hstep, voffA);
  if (wr == 1) PG8_BAR;
  PG8_WAIT_V(4); PG8_BAR;
  PG8_STAGE(PG8_SB(1, 0), cB + kstep, voffB); PG8_STAGE(PG8_SA(1, 0), cA + kstep, voffA); PG8_STAGE(PG8_SB(1, 1), cB + hstep + kstep, voffB);
  PG8_WAIT_V(6); PG8_BAR;
  for (;;) {
    const bool has_next = S.next(ui + 1, nxt);
    const char* nA = has_next ? (const char*)g.A + (size_t)nxt.pm * tstep : cA; const char* nB = has_next ? (const char*)g.Bt + (size_t)nxt.pn * tstep : cB;
    for (int t = 0; t < nt; t += 2) {
      const bool last = (t == nt - 2);
      const char* a1 = cA + (size_t)(t + 1) * kstep;
      const char* a2 = last ? nA : cA + (size_t)(t + 2) * kstep; const char* b2 = last ? nB : cB + (size_t)(t + 2) * kstep;
      const char* a3 = a2 + kstep; const char* b3 = b2 + kstep;
      PG8_LDB(B0, 0, 0); PG8_SCHED; PG8_LDA(At, 0, 0); PG8_STAGE(PG8_SA(1, 1), a1 + hstep, voffA);
      PG8_WAIT_L(8); PG8_BAR; PG8_WAIT_L(0); PG8_MMA(0, 0, At, B0); PG8_BAR; PG8_SCHED;
      PG8_LDB(B1, 0, 1); PG8_STAGE(PG8_SB(0, 0), b2, voffB);
      PG8_BAR; PG8_WAIT_L(0); PG8_MMA(0, 1, At, B1); PG8_BAR;
      PG8_LDA(At, 0, 1); PG8_STAGE(PG8_SA(0, 0), a2, voffA);
      PG8_BAR; PG8_WAIT_L(0); PG8_MMA(1, 0, At, B0); PG8_BAR; PG8_SCHED;
      PG8_STAGE(PG8_SB(0, 1), b2 + hstep, voffB);
      PG8_WAIT_V(6); PG8_BAR; PG8_MMA(1, 1, At, B1); PG8_BAR;
      PG8_LDB(B0, 1, 0); PG8_SCHED; PG8_LDA(At, 1, 0); PG8_STAGE(PG8_SA(0, 1), a2 + hstep, voffA);
      PG8_WAIT_L(8); PG8_BAR; PG8_WAIT_L(0); PG8_MMA(0, 0, At, B0); PG8_BAR; PG8_SCHED;
      PG8_LDB(B1, 1, 1); PG8_STAGE(PG8_SB(1, 0), b3, voffB);
      PG8_BAR; PG8_WAIT_L(0); PG8_MMA(0, 1, At, B1); PG8_BAR;
      PG8_LDA(At, 1, 1); PG8_STAGE(PG8_SA(1, 0), a3, voffA);
      PG8_BAR; PG8_WAIT_L(0); PG8_MMA(1, 0, At, B0); PG8_BAR; PG8_SCHED;
      PG8_STAGE(PG8_SB(1, 1), b3 + hstep, voffB);
      PG8_WAIT_V(6); PG8_BAR; PG8_MMA(1, 1, At, B1); PG8_BAR;
    }
    if constexpr (!Epi::AFTER_DRAIN) E(acc, cur, wr, wc, fr, fq);
    if (!has_next) break;
#pragma unroll
    for (int a = 0; a < 2; ++a)
#pragma unroll
      for (int b = 0; b < 2; ++b)
#pragma unroll
        for (int m = 0; m < 4; ++m)
#pragma unroll
          for (int n = 0; n < 2; ++n) acc[a][b][m][n] = (f32x4){0.f, 0.f, 0.f, 0.f};
    cur = nxt; cA = nA; cB = nB; ++ui;
  }
  PG8_WAIT_V(0);
  if (wr == 0) PG8_BAR;
  PG8_BAR;
  if constexpr (Epi::AFTER_DRAIN) E(acc, cur, wr, wc, fr, fq);
#undef PG8_SA
#undef PG8_SB
#undef PG8_STAGE
#undef PG8_LDA
#undef PG8_LDB
#undef PG8_MMA
#undef PG8_WAIT_V
#undef PG8_WAIT_L
#undef PG8_BAR
#undef PG8_SCHED
}
}

typedef f32x4 AccT[2][2][4][2];
#define EPI_FENCE() asm volatile("" ::: "memory")
__device__ __forceinline__ u32x4 pack8(f32x4 a, f32x4 b) { u32x4 w; w.x = cvt_pk_bf16(a[0], a[1]); w.y = cvt_pk_bf16(a[2], a[3]); w.z = cvt_pk_bf16(b[0], b[1]); w.w = cvt_pk_bf16(b[2], b[3]); return w; }
__device__ __forceinline__ float dot4(f32x4 a) { return (a[0] * a[0] + a[1] * a[1]) + (a[2] * a[2] + a[3] * a[3]); }

struct EpiProj {
  static constexpr bool PERM = true, AFTER_DRAIN = false;
  bf16_t *cq, *ckv, *kr, *dq, *dk, *dv; float *ss_cq, *ss_ckv; const float *g_q, *g_kv, *cos_d, *sin_d, *cos_r, *sin_r;
  __device__ __forceinline__ void operator()(const AccT& acc, const pg8::Unit& u, int wr, int wc, int fr, int fq) const {
    const int row0 = u.pm * 256 + wr * 64 + fr, cw = wc * 32 + 8 * fq, pn = u.pn;
    if (pn < 3) {
      bf16_t* dst = pn < 2 ? cq : ckv; const int ld = pn < 2 ? 512 : 256, colt = pn < 2 ? pn * 256 : 0; const float* g = pn < 2 ? g_q : g_kv; float* ss = pn < 2 ? ss_cq : ss_ckv;
      f32x4 gv[2][2];
#pragma unroll
      for (int bj = 0; bj < 2; ++bj)
#pragma unroll
        for (int n = 0; n < 2; ++n) gv[bj][n] = *(const f32x4*)(g + colt + bj * 128 + cw + 4 * n);
#pragma unroll
      for (int ai = 0; ai < 2; ++ai)
#pragma unroll
        for (int m = 0; m < 4; ++m) { const int row = row0 + ai * 128 + m * 16; float s = 0.f;
#pragma unroll
          for (int bj = 0; bj < 2; ++bj) { const f32x4 v0 = acc[ai][bj][m][0], v1 = acc[ai][bj][m][1]; s += dot4(v0) + dot4(v1);
            *(u32x4*)(dst + (size_t)row * ld + colt + bj * 128 + cw) = pack8(v0 * gv[bj][0], v1 * gv[bj][1]); }
          s += __shfl_xor(s, 16); s += __shfl_xor(s, 32);
          if (fq == 0) unsafeAtomicAdd(ss + row, s); }
    } else if (pn == 3) {
      if (wc == 0) {
#pragma unroll
        for (int ai = 0; ai < 2; ++ai)
#pragma unroll
          for (int m = 0; m < 4; ++m) { const int row = row0 + ai * 128 + m * 16;
            f32x4 lo[2], hi[2];
#pragma unroll
            for (int n = 0; n < 2; ++n) { const f32x4 c = *(const f32x4*)(cos_r + (size_t)row * 32 + 8 * fq + 4 * n), s = *(const f32x4*)(sin_r + (size_t)row * 32 + 8 * fq + 4 * n);
              const f32x4 a = acc[ai][0][m][n], b = acc[ai][1][m][n]; lo[n] = a * c - b * s; hi[n] = a * s + b * c; }
            *(u32x4*)(kr + (size_t)row * 64 + 8 * fq) = pack8(lo[0], lo[1]);
            *(u32x4*)(kr + (size_t)row * 64 + 32 + 8 * fq) = pack8(hi[0], hi[1]); if (m & 1) EPI_FENCE(); }
      }
    } else if (pn < 12) {
      bf16_t* dst = pn < 8 ? dq : dk; const int head = (pn - 4) & 3, sub = wc >> 1, i0 = 32 * (wc & 1) + 8 * fq;
#pragma unroll
      for (int ai = 0; ai < 2; ++ai)
#pragma unroll
        for (int m = 0; m < 4; ++m) { const int row = row0 + ai * 128 + m * 16;
          f32x4 lo[2], hi[2];
#pragma unroll
          for (int n = 0; n < 2; ++n) { const f32x4 c = *(const f32x4*)(cos_d + (size_t)row * 64 + i0 + 4 * n), s = *(const f32x4*)(sin_d + (size_t)row * 64 + i0 + 4 * n);
            const f32x4 a = acc[ai][0][m][n], b = acc[ai][1][m][n]; lo[n] = a * c - b * s; hi[n] = a * s + b * c; }
          bf16_t* p = dst + (size_t)row * 1024 + head * 256 + sub * 128 + i0;
          *(u32x4*)p = pack8(lo[0], lo[1]); *(u32x4*)(p + 64) = pack8(hi[0], hi[1]); if (m & 1) EPI_FENCE(); }
    } else {
      const int head = pn - 12;
#pragma unroll
      for (int ai = 0; ai < 2; ++ai)
#pragma unroll
        for (int m = 0; m < 4; ++m) { const int row = row0 + ai * 128 + m * 16;
#pragma unroll
          for (int bj = 0; bj < 2; ++bj) *(u32x4*)(dv + (size_t)row * 1024 + head * 256 + bj * 128 + cw) = pack8(acc[ai][bj][m][0], acc[ai][bj][m][1]); }
    }
  }
};
struct EpiQ {
  static constexpr bool PERM = true, AFTER_DRAIN = false;
  bf16_t *qn, *qr; const float *ss, *cos_r, *sin_r;
  __device__ __forceinline__ void operator()(const AccT& acc, const pg8::Unit& u, int wr, int wc, int fr, int fq) const {
    const int row0 = u.pm * 256 + wr * 64 + fr, cw = wc * 32 + 8 * fq, pn = u.pn;
    float rr[2][4];
#pragma unroll
    for (int ai = 0; ai < 2; ++ai)
#pragma unroll
      for (int m = 0; m < 4; ++m) rr[ai][m] = ss[row0 + ai * 128 + m * 16];
    if (pn < 4) {
#pragma unroll
      for (int ai = 0; ai < 2; ++ai)
#pragma unroll
        for (int m = 0; m < 4; ++m) { const int row = row0 + ai * 128 + m * 16; const float r = rsqrtf(rr[ai][m] * (1.f / 512.f) + NORM_EPS);
#pragma unroll
          for (int bj = 0; bj < 2; ++bj) *(u32x4*)(qn + (size_t)row * 1024 + pn * 256 + bj * 128 + cw) = pack8(acc[ai][bj][m][0] * r, acc[ai][bj][m][1] * r);
          EPI_FENCE(); }
    } else {
      const int head = 4 * (pn - 4) + wc;
#pragma unroll
      for (int ai = 0; ai < 2; ++ai)
#pragma unroll
        for (int m = 0; m < 4; ++m) { const int row = row0 + ai * 128 + m * 16; const float r = rsqrtf(rr[ai][m] * (1.f / 512.f) + NORM_EPS);
          bf16_t* p = qr + (size_t)row * 512 + head * 64 + 8 * fq;
#pragma unroll
          for (int n = 0; n < 2; ++n) { const f32x4 c = *(const f32x4*)(cos_r + (size_t)row * 32 + 8 * fq + 4 * n), s = *(const f32x4*)(sin_r + (size_t)row * 32 + 8 * fq + 4 * n);
            const f32x4 a = acc[ai][0][m][n] * r, b = acc[ai][1][m][n] * r, lo = a * c - b * s, hi = a * s + b * c;
            u32x2 w0, w1; w0.x = cvt_pk_bf16(lo[0], lo[1]); w0.y = cvt_pk_bf16(lo[2], lo[3]); w1.x = cvt_pk_bf16(hi[0], hi[1]); w1.y = cvt_pk_bf16(hi[2], hi[3]);
            *(u32x2*)(p + 4 * n) = w0; *(u32x2*)(p + 32 + 4 * n) = w1; }
          EPI_FENCE(); }
    }
  }
};
struct EpiKV {
  static constexpr bool PERM = true, AFTER_DRAIN = false;
  bf16_t *kn, *vm; const float* ss;
  __device__ __forceinline__ void operator()(const AccT& acc, const pg8::Unit& u, int wr, int wc, int fr, int fq) const {
    const int row0 = u.pm * 256 + wr * 64 + fr, cw = wc * 32 + 8 * fq, pn = u.pn;
    float rr[2][4];
#pragma unroll
    for (int ai = 0; ai < 2; ++ai)
#pragma unroll
      for (int m = 0; m < 4; ++m) rr[ai][m] = ss[row0 + ai * 128 + m * 16];
#pragma unroll
    for (int ai = 0; ai < 2; ++ai)
#pragma unroll
      for (int m = 0; m < 4; ++m) { const int row = row0 + ai * 128 + m * 16; const float r = rsqrtf(rr[ai][m] * (1.f / 256.f) + NORM_EPS);
        *(u32x4*)(kn + (size_t)row * 1024 + pn * 128 + cw) = pack8(acc[ai][0][m][0] * r, acc[ai][0][m][1] * r);
        *(u32x4*)(vm + (size_t)row * 1024 + pn * 128 + cw) = pack8(acc[ai][1][m][0] * r, acc[ai][1][m][1] * r); EPI_FENCE(); }
  }
};
struct EpiScale {
  static constexpr bool PERM = true, AFTER_DRAIN = false;
  bf16_t* out; int ld; const float* ss; float inv_n;
  __device__ __forceinline__ void operator()(const AccT& acc, const pg8::Unit& u, int wr, int wc, int fr, int fq) const {
    const int row0 = u.pm * 256 + wr * 64 + fr, cw = wc * 32 + 8 * fq, pn = u.pn;
    float rr[2][4];
#pragma unroll
    for (int ai = 0; ai < 2; ++ai)
#pragma unroll
      for (int m = 0; m < 4; ++m) rr[ai][m] = ss ? ss[row0 + ai * 128 + m * 16] : 0.f;
#pragma unroll
    for (int ai = 0; ai < 2; ++ai)
#pragma unroll
      for (int m = 0; m < 4; ++m) { const int row = row0 + ai * 128 + m * 16; const float r = ss ? rsqrtf(rr[ai][m] * inv_n + NORM_EPS) : 1.f;
#pragma unroll
        for (int bj = 0; bj < 2; ++bj) *(u32x4*)(out + (size_t)row * ld + pn * 256 + bj * 128 + cw) = pack8(acc[ai][bj][m][0] * r, acc[ai][bj][m][1] * r);
        EPI_FENCE(); }
  }
};
struct EpiRes {
  static constexpr bool PERM = true, AFTER_DRAIN = false;
  const float* base; float* X; bf16_t* xb; const float* g; float* ss;
  __device__ __forceinline__ void operator()(const AccT& acc, const pg8::Unit& u, int wr, int wc, int fr, int fq) const {
    const int row0 = u.pm * 256 + wr * 64 + fr, col0 = u.pn * 256 + wc * 32 + 8 * fq;
#pragma unroll
    for (int ai = 0; ai < 2; ++ai) { float sm[4];
#pragma unroll
      for (int m = 0; m < 4; ++m) { const int row = row0 + ai * 128 + m * 16; const size_t off = (size_t)row * DM + col0; float s = 0.f;
#pragma unroll
        for (int bj = 0; bj < 2; ++bj) { const int co = bj * 128;
          const f32x4 v0 = *(const f32x4*)(base + off + co) + acc[ai][bj][m][0], v1 = *(const f32x4*)(base + off + co + 4) + acc[ai][bj][m][1];
          *(f32x4*)(X + off + co) = v0; *(f32x4*)(X + off + co + 4) = v1; s += dot4(v0) + dot4(v1);
          if (xb) { const f32x4 g0 = *(const f32x4*)(g + col0 + co), g1 = *(const f32x4*)(g + col0 + co + 4); *(u32x4*)(xb + off + co) = pack8(v0 * g0, v1 * g1); } }
        s += __shfl_xor(s, 16); s += __shfl_xor(s, 32); sm[m] = s;
        if (m & 1) EPI_FENCE(); }
      unsafeAtomicAdd(ss + row0 + ai * 128 + fq * 16, fq == 0 ? sm[0] : fq == 1 ? sm[1] : fq == 2 ? sm[2] : sm[3]); }
  }
};
struct EpiFinal {
  static constexpr bool PERM = true, AFTER_DRAIN = true;
  float* X; const float* g; float* ss; unsigned* cnt;
  __device__ __forceinline__ void operator()(AccT& acc, const pg8::Unit& u, int wr, int wc, int fr, int fq) const {
    const int row0 = u.pm * 256 + wr * 64 + fr, col0 = u.pn * 256 + wc * 32 + 8 * fq;
#pragma unroll
    for (int ai = 0; ai < 2; ++ai) { float sm[4];
#pragma unroll
      for (int m = 0; m < 4; ++m) { const int row = row0 + ai * 128 + m * 16; const size_t off = (size_t)row * DM + col0; float s = 0.f;
#pragma unroll
        for (int bj = 0; bj < 2; ++bj)
#pragma unroll
          for (int n = 0; n < 2; ++n) { const int co = bj * 128 + n * 4; const f32x4 v = *(const f32x4*)(X + off + co) + acc[ai][bj][m][n]; acc[ai][bj][m][n] = v; s += dot4(v); }
        s += __shfl_xor(s, 16); s += __shfl_xor(s, 32); sm[m] = s;
        if (m & 1) EPI_FENCE(); }
      unsafeAtomicAdd(ss + row0 + ai * 128 + fq * 16, fq == 0 ? sm[0] : fq == 1 ? sm[1] : fq == 2 ? sm[2] : sm[3]); }
    asm volatile("s_waitcnt vmcnt(0)" ::: "memory");
    unsigned* cw = cnt + 64 * u.pm;
    if (fr == 0 && fq == 0) __hip_atomic_fetch_add(cw, 1u, __ATOMIC_RELAXED, __HIP_MEMORY_SCOPE_AGENT);
    { unsigned polls = 0;
      while ((unsigned)__builtin_amdgcn_readfirstlane(__hip_atomic_load(cw, __ATOMIC_RELAXED, __HIP_MEMORY_SCOPE_AGENT)) < 64u) { __builtin_amdgcn_s_sleep(2); if (++polls > (1u << 22)) break; } }
    EPI_FENCE();
#pragma unroll
    for (int ai = 0; ai < 2; ++ai)
#pragma unroll
      for (int m = 0; m < 4; ++m) { const int row = row0 + ai * 128 + m * 16; const size_t off = (size_t)row * DM + col0;
        const float r = rsqrtf(__hip_atomic_load(ss + row, __ATOMIC_RELAXED, __HIP_MEMORY_SCOPE_AGENT) * (1.f / DM) + NORM_EPS);
#pragma unroll
        for (int bj = 0; bj < 2; ++bj)
#pragma unroll
          for (int n = 0; n < 2; ++n) { const int co = bj * 128 + n * 4; const f32x4 gv = *(const f32x4*)(g + col0 + co); *(f32x4*)(X + off + co) = acc[ai][bj][m][n] * gv * r; }
        EPI_FENCE(); }
  }
};
struct EpiSwiGLU {
  static constexpr bool PERM = true, AFTER_DRAIN = false;
  bf16_t* hid; const float* ss;
  __device__ __forceinline__ void operator()(const AccT& acc, const pg8::Unit& u, int wr, int wc, int fr, int fq) const {
    typedef float f32x2 __attribute__((ext_vector_type(2)));
    const int row0 = u.pm * 256 + wr * 64 + fr, cw = wc * 32 + 8 * fq, pn = u.pn;
    float rr[2][4];
#pragma unroll
    for (int ai = 0; ai < 2; ++ai)
#pragma unroll
      for (int m = 0; m < 4; ++m) rr[ai][m] = ss[row0 + ai * 128 + m * 16];
#pragma unroll
    for (int ai = 0; ai < 2; ++ai)
#pragma unroll
      for (int m = 0; m < 4; ++m) { const int row = row0 + ai * 128 + m * 16; const float r = rsqrtf(rr[ai][m] * (1.f / 2048.f) + NORM_EPS);
        const float cr = -1.4426950408889634f * r, r2 = r * r;
        u32x4 w;
#pragma unroll
        for (int n = 0; n < 2; ++n)
#pragma unroll
          for (int hf = 0; hf < 2; ++hf) { const f32x2 g = {acc[ai][0][m][n][2 * hf], acc[ai][0][m][n][2 * hf + 1]}, up = {acc[ai][1][m][n][2 * hf], acc[ai][1][m][n][2 * hf + 1]};
            const f32x2 t = g * cr; f32x2 e; e.x = __builtin_amdgcn_exp2f(t.x); e.y = __builtin_amdgcn_exp2f(t.y);
            const f32x2 d = e + 1.0f; f32x2 q; q.x = __builtin_amdgcn_rcpf(d.x); q.y = __builtin_amdgcn_rcpf(d.y);
            const f32x2 h = (g * up) * (q * r2);
            w[n * 2 + hf] = cvt_pk_bf16(h.x, h.y); }
        *(u32x4*)(hid + (size_t)row * FFN + pn * 128 + cw) = w; EPI_FENCE(); }
  }
};

namespace at {
constexpr int KVBLK = 64;
constexpr int SHM_V = KVBLK * 128 * 2, SHM_K = KVBLK * 128 * 2, SHM_KR = KVBLK * 64 * 2;
constexpr int OFF_V = 0, OFF_K = 2 * SHM_V, OFF_KR = OFF_K + 2 * SHM_K, OFF_WS = OFF_KR + 2 * SHM_KR, OFF_QR = OFF_WS + 8 * 64 * 4, LDS_ATTN = OFF_QR + 8 * 8192;
constexpr int LDKV = 1024;
#define KSWZ(row, colB) ((row) * 256 + ((colB) ^ (((row) & 7) << 4)))
#define KRSWZ(row, chunk) ((row) * 128 + ((((chunk) ^ (((row) >> 1) & 7))) << 4))
#define SBAR() __builtin_amdgcn_sched_barrier(0)
__device__ __forceinline__ int crow(int r, int hi) { return (r & 3) + 8 * (r >> 2) + 4 * hi; }

__device__ __forceinline__ void partialSM(f32x16& p0, f32x16& p1, float& m_reg, float& mn, float& alpha, const float C, const float thr_raw) {
  float pmax = p0[0];
#pragma unroll
  for (int r = 1; r < 16; ++r) pmax = fmaxf(pmax, p0[r]);
#pragma unroll
  for (int r = 0; r < 16; ++r) pmax = fmaxf(pmax, p1[r]);
  { auto rr = __builtin_amdgcn_permlane32_swap(__float_as_uint(pmax), __float_as_uint(pmax), false, false);
    pmax = fmaxf(__uint_as_float(rr[0]), __uint_as_float(rr[1])); }
  if (__builtin_expect(__all(pmax - m_reg <= thr_raw), 1)) { mn = m_reg; alpha = 1.f; }
  else { mn = fmaxf(m_reg, pmax); alpha = __builtin_amdgcn_exp2f((m_reg - mn) * C); m_reg = mn; }
  const float mnC = -mn * C;
#pragma unroll
  for (int r = 0; r < 16; ++r) p0[r] = fmaf(p0[r], C, mnC);
#pragma unroll
  for (int r = 0; r < 16; ++r) p1[r] = fmaf(p1[r], C, mnC);
#pragma unroll
  for (int r = 0; r < 16; ++r) p0[r] = __builtin_amdgcn_exp2f(p0[r]);
}
__device__ __forceinline__ void finishSM(f32x16& p0, f32x16& p1, float alpha, float& l_reg, bf16x8& pa0, bf16x8& pa1, bf16x8& pa2, bf16x8& pa3) {
#pragma unroll
  for (int r = 0; r < 16; ++r) p1[r] = __builtin_amdgcn_exp2f(p1[r]);
  float ps = 0;
#pragma unroll
  for (int r = 0; r < 16; ++r) ps += p0[r];
#pragma unroll
  for (int r = 0; r < 16; ++r) ps += p1[r];
  { auto rr = __builtin_amdgcn_permlane32_swap(__float_as_uint(ps), __float_as_uint(ps), false, false);
    ps = __uint_as_float(rr[0]) + __uint_as_float(rr[1]); }
  l_reg = l_reg * alpha + ps;
#define PK4(P, BASE, OUT) do { unsigned a0 = cvt_pk_bf16(P[BASE + 0], P[BASE + 1]), a1 = cvt_pk_bf16(P[BASE + 2], P[BASE + 3]);   \
    unsigned b0 = cvt_pk_bf16(P[BASE + 4], P[BASE + 5]), b1 = cvt_pk_bf16(P[BASE + 6], P[BASE + 7]);                              \
    auto r0 = __builtin_amdgcn_permlane32_swap(a0, b0, false, false); auto r1 = __builtin_amdgcn_permlane32_swap(a1, b1, false, false); \
    u32x4 w = {r0[0], r1[0], r0[1], r1[1]}; OUT = *reinterpret_cast<bf16x8*>(&w); } while (0)
  PK4(p0, 0, pa0); PK4(p0, 8, pa1); PK4(p1, 0, pa2); PK4(p1, 8, pa3);
#undef PK4
}
template <int NQK, int NREG>
__device__ __forceinline__ void qkt(f32x16& p0, f32x16& p1, const char* Ks, const char* KRs, const bf16x8* qr, const char* qrl, int r32, int hi) {
  p0 = f32x16{}; p1 = f32x16{};
#pragma unroll
  for (int d0 = 0; d0 < 8; ++d0) { const int cb = (d0 * 16 + hi * 8) * 2;
    bf16x8 b0 = *reinterpret_cast<const bf16x8*>(Ks + KSWZ(r32, cb));
    bf16x8 b1 = *reinterpret_cast<const bf16x8*>(Ks + KSWZ(32 + r32, cb));
    bf16x8 qq; if (d0 < NREG) qq = qr[d0 < NREG ? d0 : 0]; else qq = *reinterpret_cast<const bf16x8*>(qrl + KRSWZ(r32, (d0 - 4) * 2 + hi));
    p0 = __builtin_amdgcn_mfma_f32_32x32x16_bf16(b0, qq, p0, 0, 0, 0);
    p1 = __builtin_amdgcn_mfma_f32_32x32x16_bf16(b1, qq, p1, 0, 0, 0); }
  if constexpr (NQK == 12) {
#pragma unroll
    for (int d0 = 0; d0 < 4; ++d0) { const int ch = d0 * 2 + hi;
      bf16x8 b0 = *reinterpret_cast<const bf16x8*>(KRs + KRSWZ(r32, ch));
      bf16x8 b1 = *reinterpret_cast<const bf16x8*>(KRs + KRSWZ(32 + r32, ch));
      const bf16x8 qq = *reinterpret_cast<const bf16x8*>(qrl + 4096 + KRSWZ(r32, ch));
      p0 = __builtin_amdgcn_mfma_f32_32x32x16_bf16(b0, qq, p0, 0, 0, 0);
      p1 = __builtin_amdgcn_mfma_f32_32x32x16_bf16(b1, qq, p1, 0, 0, 0); }
  }
}
__device__ __forceinline__ int v_st(int k, int c) { const int kk = (k & ~0xC) | ((k & 4) << 1) | ((k & 8) >> 1); return ((kk >> 3) * 4 + (c >> 5)) * 512 + ((kk & 7) * 32 + (c & 31)) * 2; }
__device__ __forceinline__ int v_rd_base(int lane) { return ((lane & 3) << 3) | (((lane >> 2) & 3) << 6) | (((lane >> 4) & 1) << 5) | (((lane >> 5) & 1) << 8); }
constexpr int v_rd_off(int d0, int ks, int half) { return d0 * 512 + ks * 4096 + half * 2048; }
template <int OFF> __device__ __forceinline__ s16x4 tr_read(int vb) {
  s16x4 r; asm volatile("ds_read_b64_tr_b16 %0, %1 offset:%2" : "=&v"(r) : "v"(vb), "i"(OFF) : "memory"); return r;
}
template <int D0> __device__ __forceinline__ void pv_one(f32x16& od, int vb, bf16x8 pa0, bf16x8 pa1, bf16x8 pa2, bf16x8 pa3) {
  const s16x4 l0 = tr_read<v_rd_off(D0, 0, 0)>(vb), h0 = tr_read<v_rd_off(D0, 0, 1)>(vb), l1 = tr_read<v_rd_off(D0, 1, 0)>(vb), h1 = tr_read<v_rd_off(D0, 1, 1)>(vb);
  const s16x4 l2 = tr_read<v_rd_off(D0, 2, 0)>(vb), h2 = tr_read<v_rd_off(D0, 2, 1)>(vb), l3 = tr_read<v_rd_off(D0, 3, 0)>(vb), h3 = tr_read<v_rd_off(D0, 3, 1)>(vb);
  asm volatile("s_waitcnt lgkmcnt(0)" ::: "memory"); SBAR();
#define PK(L, H) (bf16x8){L[0], L[1], L[2], L[3], H[0], H[1], H[2], H[3]}
  od = __builtin_amdgcn_mfma_f32_32x32x16_bf16(pa0, PK(l0, h0), od, 0, 0, 0);
  od = __builtin_amdgcn_mfma_f32_32x32x16_bf16(pa1, PK(l1, h1), od, 0, 0, 0);
  od = __builtin_amdgcn_mfma_f32_32x32x16_bf16(pa2, PK(l2, h2), od, 0, 0, 0);
  od = __builtin_amdgcn_mfma_f32_32x32x16_bf16(pa3, PK(l3, h3), od, 0, 0, 0);
#undef PK
}
__device__ __forceinline__ void pv_d0(f32x16* o, int vb, bf16x8 pa0, bf16x8 pa1, bf16x8 pa2, bf16x8 pa3) {
  pv_one<0>(o[0], vb, pa0, pa1, pa2, pa3); pv_one<1>(o[1], vb, pa0, pa1, pa2, pa3); pv_one<2>(o[2], vb, pa0, pa1, pa2, pa3); pv_one<3>(o[3], vb, pa0, pa1, pa2, pa3);
}

template <int NQK, int LDQ, int LDQR, int SD, int NREG>
__device__ __forceinline__ void attn_core(f32x16 (&o)[4], const bf16_t* __restrict__ Qb, const bf16_t* __restrict__ Qrb, const bf16_t* __restrict__ Kh, const bf16_t* __restrict__ Krh,
                                          const bf16_t* __restrict__ Vh, const int seq, const float C, const float thr_raw, char* lds) {
  const int tid = threadIdx.x, wid = tid >> 6, lane = tid & 63, r32 = lane & 31, hi = lane >> 5;
  char* V_lds = lds + OFF_V; char* K_lds = lds + OFF_K; char* KR_lds = lds + OFF_KR;
  float* ws = (float*)(lds + OFF_WS) + wid * 64; float* li_l = ws; float* al_l = ws + 32;
  float m_reg = -1e30f, l_reg = 0;
#pragma unroll
  for (int d = 0; d < 4; ++d) o[d] = f32x16{};
  bf16x8 qr[NREG]; char* qrl = lds + OFF_QR + wid * 8192;
  { const bf16_t* Qw = Qb + (long)(wid * 32 + r32) * LDQ + hi * 8;
#pragma unroll
    for (int d0 = 0; d0 < NREG; ++d0) { qr[d0] = *reinterpret_cast<const bf16x8*>(Qw + d0 * 16); asm volatile("" : "+v"(qr[d0])); }
    if constexpr (NREG == 4) {
#pragma unroll
      for (int d0 = 0; d0 < 4; ++d0) *reinterpret_cast<bf16x8*>(qrl + KRSWZ(r32, d0 * 2 + hi)) = *reinterpret_cast<const bf16x8*>(Qw + (4 + d0) * 16); }
    if constexpr (NQK == 12) { const bf16_t* Qw2 = Qrb + (long)(wid * 32 + r32) * LDQR + hi * 8;
#pragma unroll
      for (int d0 = 0; d0 < 4; ++d0) *reinterpret_cast<bf16x8*>(qrl + 4096 + KRSWZ(r32, d0 * 2 + hi)) = *reinterpret_cast<const bf16x8*>(Qw2 + d0 * 16); } }
  const int sr = tid >> 4, sc = (tid & 15) * 8, vst0 = v_st(sr, sc), vst1 = v_st(32 + sr, sc);
  const unsigned soff = (unsigned)(sr * LDKV + sc);
  const int krr = tid >> 3, krc = tid & 7;
  const int vb0 = (int)(uintptr_t)(LAS char*)V_lds + v_rd_base(lane);
  struct { bf16x8 vs0, vs1, ks0, ks1, kr; } sr_[SD];
#define SLOAD(i, k0) do { const bf16_t* vb_ = Vh + (size_t)(k0) * LDKV; const bf16_t* kb_ = Kh + (size_t)(k0) * LDKV;     \
    sr_[i].vs0 = *reinterpret_cast<const bf16x8*>(vb_ + soff); sr_[i].vs1 = *reinterpret_cast<const bf16x8*>(vb_ + 32 * LDKV + soff); \
    sr_[i].ks0 = *reinterpret_cast<const bf16x8*>(kb_ + soff); sr_[i].ks1 = *reinterpret_cast<const bf16x8*>(kb_ + 32 * LDKV + soff); \
    if constexpr (NQK == 12) sr_[i].kr = *reinterpret_cast<const bf16x8*>(&Krh[(long)((k0) + krr) * 64 + krc * 8]); } while (0)
#define SWRITE(b, i) do { *(bf16x8*)(V_lds + (b) * SHM_V + vst0) = sr_[i].vs0;          \
    *(bf16x8*)(V_lds + (b) * SHM_V + vst1) = sr_[i].vs1; const int kc = sc * 2;               \
    *(bf16x8*)(K_lds + (b) * SHM_K + KSWZ(sr, kc)) = sr_[i].ks0;                       \
    *(bf16x8*)(K_lds + (b) * SHM_K + KSWZ(32 + sr, kc)) = sr_[i].ks1; \
    if constexpr (NQK == 12) *(bf16x8*)(KR_lds + (b) * SHM_KR + KRSWZ(krr, krc)) = sr_[i].kr; } while (0)
#define SWAIT() do { if constexpr (SD == 1) asm volatile("s_waitcnt vmcnt(0)" ::: "memory"); else if constexpr (NQK == 12) asm volatile("s_waitcnt vmcnt(5)" ::: "memory"); else asm volatile("s_waitcnt vmcnt(4)" ::: "memory"); } while (0)
#define RESC(a) do { if (__any((a) < 1.f)) { if (hi == 0) al_l[r32] = (a); asm volatile("s_waitcnt lgkmcnt(0)" ::: "memory"); \
    _Pragma("unroll") for (int d = 0; d < 4; ++d) _Pragma("unroll") for (int r = 0; r < 16; ++r) o[d][r] *= al_l[crow(r, hi)]; } } while (0)
  f32x16 pA0, pA1, pB0, pB1; float mnA, mnB, alA, alB; bf16x8 pa0, pa1, pa2, pa3; const int NT = seq / KVBLK;
  constexpr int SE = 0, SO = SD - 1;
  SLOAD(SE, 0); asm volatile("s_waitcnt vmcnt(0)" ::: "memory"); SWRITE(0, SE); __syncthreads();
  qkt<NQK, NREG>(pA0, pA1, K_lds, KR_lds, qr, qrl, r32, hi); partialSM(pA0, pA1, m_reg, mnA, alA, C, thr_raw);
  SLOAD(SO, KVBLK); if constexpr (SD == 2) { if (2 < NT) SLOAD(SE, 2 * KVBLK); }
  SWAIT(); SWRITE(1, SO); __syncthreads();
  for (int j = 1; j + 1 < NT; j += 2) {
    SBAR(); qkt<NQK, NREG>(pB0, pB1, K_lds + SHM_K, KR_lds + SHM_KR, qr, qrl, r32, hi);
    finishSM(pA0, pA1, alA, l_reg, pa0, pa1, pa2, pa3); SBAR();
    SLOAD(SO, (j + SD) * KVBLK); SBAR();
    pv_d0(o, vb0, pa0, pa1, pa2, pa3); partialSM(pB0, pB1, m_reg, mnB, alB, C, thr_raw);
    __syncthreads(); SWAIT(); SWRITE(0, SE);
    RESC(alB); __syncthreads();
    SBAR(); qkt<NQK, NREG>(pA0, pA1, K_lds, KR_lds, qr, qrl, r32, hi);
    finishSM(pB0, pB1, alB, l_reg, pa0, pa1, pa2, pa3); SBAR();
    if (SD == 1 || j + 3 < NT) SLOAD(SE, (j + 1 + SD) * KVBLK); SBAR();
    pv_d0(o, vb0 + SHM_V, pa0, pa1, pa2, pa3); partialSM(pA0, pA1, m_reg, mnA, alA, C, thr_raw);
    __syncthreads(); SWAIT(); SWRITE(1, SO);
    RESC(alA); __syncthreads();
  }
  SBAR(); qkt<NQK, NREG>(pB0, pB1, K_lds + SHM_K, KR_lds + SHM_KR, qr, qrl, r32, hi);
  finishSM(pA0, pA1, alA, l_reg, pa0, pa1, pa2, pa3); SBAR();
  pv_d0(o, vb0, pa0, pa1, pa2, pa3); partialSM(pB0, pB1, m_reg, mnB, alB, C, thr_raw);
  __syncthreads(); RESC(alB);
  finishSM(pB0, pB1, alB, l_reg, pa0, pa1, pa2, pa3); SBAR();
  pv_d0(o, vb0 + SHM_V, pa0, pa1, pa2, pa3);
  if (hi == 0) li_l[r32] = l_reg; asm volatile("s_waitcnt lgkmcnt(0)" ::: "memory");
#pragma unroll
  for (int r = 0; r < 16; ++r) { const float rl = __builtin_amdgcn_rcpf(li_l[crow(r, hi)]);
#pragma unroll
    for (int d = 0; d < 4; ++d) o[d][r] *= rl; }
  __syncthreads();
#undef SLOAD
#undef SWRITE
#undef SWAIT
#undef RESC
}
template <int NQK, int LDQ, int LDQR, int NREG>
__device__ __forceinline__ void attn_core_simple(f32x16 (&o)[4], const bf16_t* __restrict__ Qb, const bf16_t* __restrict__ Qrb, const bf16_t* __restrict__ Kh, const bf16_t* __restrict__ Krh,
                                                 const bf16_t* __restrict__ Vh, const int seq, const float C, const float thr_raw, char* lds) {
  const int tid = threadIdx.x, wid = tid >> 6, lane = tid & 63, r32 = lane & 31, hi = lane >> 5;
  char* V_lds = lds + OFF_V; char* K_lds = lds + OFF_K; char* KR_lds = lds + OFF_KR;
  float* ws = (float*)(lds + OFF_WS) + wid * 64; float* li_l = ws; float* al_l = ws + 32;
  float m_reg = -1e30f, l_reg = 0;
#pragma unroll
  for (int d = 0; d < 4; ++d) o[d] = f32x16{};
  bf16x8 qr[NREG]; char* qrl = lds + OFF_QR + wid * 8192;
  { const bf16_t* Qw = Qb + (long)(wid * 32 + r32) * LDQ + hi * 8;
#pragma unroll
    for (int d0 = 0; d0 < NREG; ++d0) { qr[d0] = *reinterpret_cast<const bf16x8*>(Qw + d0 * 16); asm volatile("" : "+v"(qr[d0])); }
    if constexpr (NREG == 4) {
#pragma unroll
      for (int d0 = 0; d0 < 4; ++d0) *reinterpret_cast<bf16x8*>(qrl + KRSWZ(r32, d0 * 2 + hi)) = *reinterpret_cast<const bf16x8*>(Qw + (4 + d0) * 16); }
    if constexpr (NQK == 12) { const bf16_t* Qw2 = Qrb + (long)(wid * 32 + r32) * LDQR + hi * 8;
#pragma unroll
      for (int d0 = 0; d0 < 4; ++d0) *reinterpret_cast<bf16x8*>(qrl + 4096 + KRSWZ(r32, d0 * 2 + hi)) = *reinterpret_cast<const bf16x8*>(Qw2 + d0 * 16); } }
  const int sr = tid >> 4, sc = (tid & 15) * 8, vst0 = v_st(sr, sc), vst1 = v_st(32 + sr, sc);
  const int krr = tid >> 3, krc = tid & 7;
  const int vb0 = (int)(uintptr_t)(LAS char*)V_lds + v_rd_base(lane);
  bf16x8 vs0, vs1, ks0, ks1, kr;
#define SLOAD1(k0) do { vs0 = *reinterpret_cast<const bf16x8*>(&Vh[(long)((k0) + sr) * LDKV + sc]); vs1 = *reinterpret_cast<const bf16x8*>(&Vh[(long)((k0) + 32 + sr) * LDKV + sc]); \
    ks0 = *reinterpret_cast<const bf16x8*>(&Kh[(long)((k0) + sr) * LDKV + sc]); ks1 = *reinterpret_cast<const bf16x8*>(&Kh[(long)((k0) + 32 + sr) * LDKV + sc]); \
    if constexpr (NQK == 12) kr = *reinterpret_cast<const bf16x8*>(&Krh[(long)((k0) + krr) * 64 + krc * 8]); } while (0)
#define SWRITE1(b) do { *(bf16x8*)(V_lds + (b) * SHM_V + vst0) = vs0; *(bf16x8*)(V_lds + (b) * SHM_V + vst1) = vs1; const int kc = sc * 2; \
    *(bf16x8*)(K_lds + (b) * SHM_K + KSWZ(sr, kc)) = ks0; *(bf16x8*)(K_lds + (b) * SHM_K + KSWZ(32 + sr, kc)) = ks1; \
    if constexpr (NQK == 12) *(bf16x8*)(KR_lds + (b) * SHM_KR + KRSWZ(krr, krc)) = kr; } while (0)
  f32x16 p0, p1; float mn, al; bf16x8 pa0, pa1, pa2, pa3; const int NT = seq / KVBLK;
  SLOAD1(0); SWRITE1(0); __syncthreads();
  if (1 < NT) SLOAD1(KVBLK);
  for (int j = 0; j < NT; ++j) {
    const int b = j & 1;
    SBAR(); qkt<NQK, NREG>(p0, p1, K_lds + b * SHM_K, KR_lds + b * SHM_KR, qr, qrl, r32, hi);
    partialSM(p0, p1, m_reg, mn, al, C, thr_raw);
    if (__any(al < 1.f)) { if (hi == 0) al_l[r32] = al; asm volatile("s_waitcnt lgkmcnt(0)" ::: "memory");
#pragma unroll
      for (int d = 0; d < 4; ++d)
#pragma unroll
        for (int r = 0; r < 16; ++r) o[d][r] *= al_l[crow(r, hi)]; }
    finishSM(p0, p1, al, l_reg, pa0, pa1, pa2, pa3); SBAR();
    pv_d0(o, vb0 + b * SHM_V, pa0, pa1, pa2, pa3);
    if (j + 1 < NT) { SWRITE1(b ^ 1); if (j + 2 < NT) SLOAD1((j + 2) * KVBLK); }
    __syncthreads();
  }
  if (hi == 0) li_l[r32] = l_reg; asm volatile("s_waitcnt lgkmcnt(0)" ::: "memory");
#pragma unroll
  for (int r = 0; r < 16; ++r) { const float rl = __builtin_amdgcn_rcpf(li_l[crow(r, hi)]);
#pragma unroll
    for (int d = 0; d < 4; ++d) o[d][r] *= rl; }
#undef SLOAD1
#undef SWRITE1
}
template <int NQK, int LDQ, int LDQR, int NREG>
__device__ __forceinline__ void attn_core_stag(f32x16 (&o)[4], const bf16_t* __restrict__ Qb, const bf16_t* __restrict__ Qrb, const bf16_t* __restrict__ Kh, const bf16_t* __restrict__ Krh,
                                                 const bf16_t* __restrict__ Vh, const int seq, const float C, const float thr_raw, char* lds) {
  const int tid = threadIdx.x, wid = tid >> 6, lane = tid & 63, r32 = lane & 31, hi = lane >> 5;
  char* V_lds = lds + OFF_V; char* K_lds = lds + OFF_K; char* KR_lds = lds + OFF_KR;
  float* ws = (float*)(lds + OFF_WS) + wid * 64; float* li_l = ws; float* al_l = ws + 32;
  float m_reg = -1e30f, l_reg = 0;
#pragma unroll
  for (int d = 0; d < 4; ++d) o[d] = f32x16{};
  bf16x8 qr[NREG]; char* qrl = lds + OFF_QR + wid * 8192;
  { const bf16_t* Qw = Qb + (long)(wid * 32 + r32) * LDQ + hi * 8;
#pragma unroll
    for (int d0 = 0; d0 < NREG; ++d0) { qr[d0] = *reinterpret_cast<const bf16x8*>(Qw + d0 * 16); asm volatile("" : "+v"(qr[d0])); }
    if constexpr (NREG == 4) {
#pragma unroll
      for (int d0 = 0; d0 < 4; ++d0) *reinterpret_cast<bf16x8*>(qrl + KRSWZ(r32, d0 * 2 + hi)) = *reinterpret_cast<const bf16x8*>(Qw + (4 + d0) * 16); }
    if constexpr (NQK == 12) { const bf16_t* Qw2 = Qrb + (long)(wid * 32 + r32) * LDQR + hi * 8;
#pragma unroll
      for (int d0 = 0; d0 < 4; ++d0) *reinterpret_cast<bf16x8*>(qrl + 4096 + KRSWZ(r32, d0 * 2 + hi)) = *reinterpret_cast<const bf16x8*>(Qw2 + d0 * 16); } }
  const int sr = tid >> 4, sc = (tid & 15) * 8, vst0 = v_st(sr, sc), vst1 = v_st(32 + sr, sc);
  const int krr = tid >> 3, krc = tid & 7;
  const int vb0 = (int)(uintptr_t)(LAS char*)V_lds + v_rd_base(lane);
  bf16x8 vs0, vs1, ks0, ks1, kr;
#define SLOAD1(k0) do { vs0 = *reinterpret_cast<const bf16x8*>(&Vh[(long)((k0) + sr) * LDKV + sc]); vs1 = *reinterpret_cast<const bf16x8*>(&Vh[(long)((k0) + 32 + sr) * LDKV + sc]); \
    ks0 = *reinterpret_cast<const bf16x8*>(&Kh[(long)((k0) + sr) * LDKV + sc]); ks1 = *reinterpret_cast<const bf16x8*>(&Kh[(long)((k0) + 32 + sr) * LDKV + sc]); \
    if constexpr (NQK == 12) kr = *reinterpret_cast<const bf16x8*>(&Krh[(long)((k0) + krr) * 64 + krc * 8]); } while (0)
#define SWRITE1(b) do { *(bf16x8*)(V_lds + (b) * SHM_V + vst0) = vs0; *(bf16x8*)(V_lds + (b) * SHM_V + vst1) = vs1; const int kc = sc * 2; \
    *(bf16x8*)(K_lds + (b) * SHM_K + KSWZ(sr, kc)) = ks0; *(bf16x8*)(K_lds + (b) * SHM_K + KSWZ(32 + sr, kc)) = ks1; \
    if constexpr (NQK == 12) *(bf16x8*)(KR_lds + (b) * SHM_KR + KRSWZ(krr, krc)) = kr; } while (0)
  f32x16 p0, p1; float mn, al; bf16x8 pa0, pa1, pa2, pa3; const int NT = seq / KVBLK;
  const int grp = wid >> 2;
  SLOAD1(0); SWRITE1(0); __syncthreads();
  if (1 < NT) SLOAD1(KVBLK);
  if (grp == 1) __syncthreads();
  for (int j = 0; j < NT; ++j) {
    const int b = j & 1;
    if (grp == 1 && j + 1 < NT) { SWRITE1(b ^ 1); if (j + 2 < NT) SLOAD1((j + 2) * KVBLK); }
    SBAR(); qkt<NQK, NREG>(p0, p1, K_lds + b * SHM_K, KR_lds + b * SHM_KR, qr, qrl, r32, hi);
    partialSM(p0, p1, m_reg, mn, al, C, thr_raw);
    if (__any(al < 1.f)) { if (hi == 0) al_l[r32] = al; asm volatile("s_waitcnt lgkmcnt(0)" ::: "memory");
#pragma unroll
      for (int d = 0; d < 4; ++d)
#pragma unroll
        for (int r = 0; r < 16; ++r) o[d][r] *= al_l[crow(r, hi)]; }
    finishSM(p0, p1, al, l_reg, pa0, pa1, pa2, pa3); SBAR();
    __syncthreads();
    pv_d0(o, vb0 + b * SHM_V, pa0, pa1, pa2, pa3);
    if (grp == 0 && j + 1 < NT) { SWRITE1(b ^ 1); if (j + 2 < NT) SLOAD1((j + 2) * KVBLK); }
    __syncthreads();
  }
  if (grp == 0) __syncthreads();
  if (hi == 0) li_l[r32] = l_reg; asm volatile("s_waitcnt lgkmcnt(0)" ::: "memory");
#pragma unroll
  for (int r = 0; r < 16; ++r) { const float rl = __builtin_amdgcn_rcpf(li_l[crow(r, hi)]);
#pragma unroll
    for (int d = 0; d < 4; ++d) o[d][r] *= rl; }
#undef SLOAD1
#undef SWRITE1
}
constexpr int R_V = 0, R_K = 3 * SHM_V, R_KR = R_K + 2 * SHM_K, R_WS = R_KR + 2 * SHM_KR, R_QR = R_WS + 8 * 64 * 4, LDS_ROT = R_QR + 8 * 4096;
template <int NQK, int LDQ, int LDQR>
__device__ __forceinline__ void attn_core_rot(f32x16 (&o)[4], const bf16_t* __restrict__ Qb, const bf16_t* __restrict__ Qrb, const bf16_t* __restrict__ Kh, const bf16_t* __restrict__ Krh,
                                              const bf16_t* __restrict__ Vh, const int seq, const float C, const float thr_raw, char* lds) {
  const int tid = threadIdx.x, wid = tid >> 6, lane = tid & 63, r32 = lane & 31, hi = lane >> 5, grp = wid >> 2;
  char* V_lds = lds + R_V; char* K_lds = lds + R_K; char* KR_lds = lds + R_KR;
  float* ws = (float*)(lds + R_WS) + wid * 64; float* li_l = ws; float* al_l = ws + 32;
  float m_reg = -1e30f, l_reg = 0;
#pragma unroll
  for (int d = 0; d < 4; ++d) o[d] = f32x16{};
  bf16x8 qr[8]; char* qrl = lds + R_QR + wid * 4096 - 4096;
  { const bf16_t* Qw = Qb + (long)(wid * 32 + r32) * LDQ + hi * 8;
#pragma unroll
    for (int d0 = 0; d0 < 8; ++d0) { qr[d0] = *reinterpret_cast<const bf16x8*>(Qw + d0 * 16); asm volatile("" : "+v"(qr[d0])); }
    if constexpr (NQK == 12) { const bf16_t* Qw2 = Qrb + (long)(wid * 32 + r32) * LDQR + hi * 8;
#pragma unroll
      for (int d0 = 0; d0 < 4; ++d0) *reinterpret_cast<bf16x8*>(qrl + 4096 + KRSWZ(r32, d0 * 2 + hi)) = *reinterpret_cast<const bf16x8*>(Qw2 + d0 * 16); } }
  const int sr = tid >> 4, sc = (tid & 15) * 8, vst0 = v_st(sr, sc), vst1 = v_st(32 + sr, sc);
  const int krr = tid >> 3, krc = tid & 7;
  const int vb0 = (int)(uintptr_t)(LAS char*)V_lds + v_rd_base(lane);
  bf16x8 vs0, vs1, ks0, ks1, kr;
#define SLOAD1(k0) do { vs0 = *reinterpret_cast<const bf16x8*>(&Vh[(long)((k0) + sr) * LDKV + sc]); vs1 = *reinterpret_cast<const bf16x8*>(&Vh[(long)((k0) + 32 + sr) * LDKV + sc]); \
    ks0 = *reinterpret_cast<const bf16x8*>(&Kh[(long)((k0) + sr) * LDKV + sc]); ks1 = *reinterpret_cast<const bf16x8*>(&Kh[(long)((k0) + 32 + sr) * LDKV + sc]); \
    if constexpr (NQK == 12) kr = *reinterpret_cast<const bf16x8*>(&Krh[(long)((k0) + krr) * 64 + krc * 8]); } while (0)
#define SWRITE1(b, vi) do { *(bf16x8*)(V_lds + (vi) * SHM_V + vst0) = vs0; *(bf16x8*)(V_lds + (vi) * SHM_V + vst1) = vs1; const int kc = sc * 2; \
    *(bf16x8*)(K_lds + (b) * SHM_K + KSWZ(sr, kc)) = ks0; *(bf16x8*)(K_lds + (b) * SHM_K + KSWZ(32 + sr, kc)) = ks1; \
    if constexpr (NQK == 12) *(bf16x8*)(KR_lds + (b) * SHM_KR + KRSWZ(krr, krc)) = kr; } while (0)
  f32x16 p0, p1; float mn, al; bf16x8 pa0, pa1, pa2, pa3; const int NT = seq / KVBLK;
  SLOAD1(0); SWRITE1(0, 0); __syncthreads();
  if (1 < NT) SLOAD1(KVBLK);
  int vprev = 2, vcur = 0, vnext = 1;
  for (int j = 0; j < NT; ++j) {
    const int b = j & 1;
    if (grp == 1 && j > 0) pv_d0(o, vb0 + vprev * SHM_V, pa0, pa1, pa2, pa3);
    SBAR(); qkt<NQK, 8>(p0, p1, K_lds + b * SHM_K, KR_lds + b * SHM_KR, qr, qrl, r32, hi);
    partialSM(p0, p1, m_reg, mn, al, C, thr_raw);
    if (__any(al < 1.f)) { if (hi == 0) al_l[r32] = al; asm volatile("s_waitcnt lgkmcnt(0)" ::: "memory");
#pragma unroll
      for (int d = 0; d < 4; ++d)
#pragma unroll
        for (int r = 0; r < 16; ++r) o[d][r] *= al_l[crow(r, hi)]; }
    finishSM(p0, p1, al, l_reg, pa0, pa1, pa2, pa3); SBAR();
    if (grp == 0) pv_d0(o, vb0 + vcur * SHM_V, pa0, pa1, pa2, pa3);
    if (j + 1 < NT) { SWRITE1(b ^ 1, vnext); if (j + 2 < NT) SLOAD1((j + 2) * KVBLK); }
    __syncthreads();
    vprev = vcur; vcur = vnext; vnext = (vnext == 2) ? 0 : vnext + 1;
  }
  if (grp == 1) pv_d0(o, vb0 + vprev * SHM_V, pa0, pa1, pa2, pa3);
  if (hi == 0) li_l[r32] = l_reg; asm volatile("s_waitcnt lgkmcnt(0)" ::: "memory");
#pragma unroll
  for (int r = 0; r < 16; ++r) { const float rl = __builtin_amdgcn_rcpf(li_l[crow(r, hi)]);
#pragma unroll
    for (int d = 0; d < 4; ++d) o[d][r] *= rl; }
  __syncthreads();
#undef SLOAD1
#undef SWRITE1
}
constexpr int PR_K = 0, PR_V = 2 * SHM_K, PR_P = PR_V + 3 * 2 * SHM_V, PR_MA = PR_P + 4 * 4096, LDS_PAIR = PR_MA + 2048 + 64;
__device__ __forceinline__ void attn_core_pair(f32x16 (&o)[4], const bf16_t* __restrict__ Qb, const bf16_t* __restrict__ Kh, const bf16_t* __restrict__ Vh, const int seq, const float C, const float thr_raw, char* lds) {
  const int tid = threadIdx.x, wid = tid >> 6, lane = tid & 63, r32 = lane & 31, hi = lane >> 5, rb = wid & 3, role = wid >> 2;
  char* K_lds = lds + PR_K; char* V_lds = lds + PR_V; char* P_l = lds + PR_P + rb * 4096 + lane * 16;
  float* ma = (float*)(lds + PR_MA); float* m_l = ma + rb * 32; float* l_l = ma + 128 + rb * 32; unsigned* fl_l = (unsigned*)(ma + 512);
#pragma unroll
  for (int d = 0; d < 4; ++d) o[d] = f32x16{};
  bf16x8 qr[8];
  { const bf16_t* Qw = Qb + (long)(rb * 32 + r32) * 1024 + hi * 8;
#pragma unroll
    for (int d0 = 0; d0 < 8; ++d0) { qr[d0] = *reinterpret_cast<const bf16x8*>(Qw + d0 * 16); asm volatile("" : "+v"(qr[d0])); } }
  const int sr = tid >> 4, sc = (tid & 15) * 8, vst0 = v_st(sr, sc), vst1 = v_st(32 + sr, sc);
  const int vb0 = (int)(uintptr_t)(LAS char*)V_lds + role * SHM_V + v_rd_base(lane);
  bf16x8 ks0, ks1, va0, va1, vb_0, vb_1;
#define PLOAD(k0) do { ks0 = *reinterpret_cast<const bf16x8*>(&Kh[(long)((k0) + sr) * LDKV + sc]); ks1 = *reinterpret_cast<const bf16x8*>(&Kh[(long)((k0) + 32 + sr) * LDKV + sc]); \
    va0 = *reinterpret_cast<const bf16x8*>(&Vh[(long)((k0) + sr) * LDKV + sc]); va1 = *reinterpret_cast<const bf16x8*>(&Vh[(long)((k0) + 32 + sr) * LDKV + sc]); \
    vb_0 = *reinterpret_cast<const bf16x8*>(&Vh[(long)((k0) + sr) * LDKV + 128 + sc]); vb_1 = *reinterpret_cast<const bf16x8*>(&Vh[(long)((k0) + 32 + sr) * LDKV + 128 + sc]); } while (0)
#define PWRITE(kb_, vi_) do { const int kc = sc * 2; *(bf16x8*)(K_lds + (kb_) * SHM_K + KSWZ(sr, kc)) = ks0; *(bf16x8*)(K_lds + (kb_) * SHM_K + KSWZ(32 + sr, kc)) = ks1; \
    char* vq = V_lds + (vi_) * (2 * SHM_V); *(bf16x8*)(vq + vst0) = va0; *(bf16x8*)(vq + vst1) = va1; *(bf16x8*)(vq + SHM_V + vst0) = vb_0; *(bf16x8*)(vq + SHM_V + vst1) = vb_1; } while (0)
  f32x16 p0, p1; bf16x8 pa0, pa1, pa2, pa3; const int NT = seq / KVBLK;
  PLOAD(0); PWRITE(0, 0); __syncthreads();
  if (1 < NT) PLOAD(KVBLK);
  int vprev = 2, vnext = 1;
  for (int j = 0; j <= NT; ++j) {
    const int kb = j & 1, par = j & 1;
    if (j >= 1) {
      const int pp = (j - 1) & 1;
      if (__builtin_amdgcn_readfirstlane(fl_l[pp * 4 + rb]) != 0u) {
        const float* al = ma + 256 + pp * 128 + rb * 32;
#pragma unroll
        for (int d = 0; d < 4; ++d)
#pragma unroll
          for (int r = 0; r < 16; ++r) o[d][r] *= al[crow(r, hi)]; }
      if (role != pp) { pa0 = *(const bf16x8*)(P_l); pa1 = *(const bf16x8*)(P_l + 1024); pa2 = *(const bf16x8*)(P_l + 2048); pa3 = *(const bf16x8*)(P_l + 3072); }
      pv_d0(o, vb0 + vprev * (2 * SHM_V), pa0, pa1, pa2, pa3);
    }
    if (j < NT && role == par) {
      float m_reg = (j == 0) ? -1e30f : m_l[r32], l_reg = (j == 0) ? 0.f : l_l[r32], mn, al;
      SBAR(); qkt<8, 8>(p0, p1, K_lds + kb * SHM_K, nullptr, qr, nullptr, r32, hi);
      partialSM(p0, p1, m_reg, mn, al, C, thr_raw);
      finishSM(p0, p1, al, l_reg, pa0, pa1, pa2, pa3); SBAR();
      *(bf16x8*)(P_l) = pa0; *(bf16x8*)(P_l + 1024) = pa1; *(bf16x8*)(P_l + 2048) = pa2; *(bf16x8*)(P_l + 3072) = pa3;
      const bool anyr = __any(al < 1.f);
      if (hi == 0) { m_l[r32] = m_reg; l_l[r32] = l_reg; ma[256 + par * 128 + rb * 32 + r32] = al; }
      if (lane == 0) fl_l[par * 4 + rb] = anyr ? 1u : 0u;
    }
    if (j + 1 < NT) { PWRITE(kb ^ 1, vnext); if (j + 2 < NT) PLOAD((j + 2) * KVBLK); }
    __syncthreads();
    vprev = (vprev == 2) ? 0 : vprev + 1; vnext = (vnext == 2) ? 0 : vnext + 1;
  }
#pragma unroll
  for (int r = 0; r < 16; ++r) { const float rl = __builtin_amdgcn_rcpf(l_l[crow(r, hi)]);
#pragma unroll
    for (int d = 0; d < 4; ++d) o[d][r] *= rl; }
  __syncthreads();
#undef PLOAD
#undef PWRITE
}
__device__ __forceinline__ void store_o_bf16(const f32x16 (&o)[4], bf16_t* Ob, int ldo) {
  const int tid = threadIdx.x, wid = tid >> 6, lane = tid & 63, r32 = lane & 31, hi = lane >> 5;
  bf16_t* Ow = Ob + (long)(wid * 32) * ldo + r32;
#pragma unroll
  for (int r = 0; r < 16; ++r) { const int orow = crow(r, hi);
#pragma unroll
    for (int d0 = 0; d0 < 4; ++d0) Ow[(long)orow * ldo + d0 * 32] = f2bf(o[d0][r]); }
}
__device__ __forceinline__ void store_o_bf16_lds(const f32x16 (&o)[4], bf16_t* Ob, int ldo, char* wl) {
  const int tid = threadIdx.x, wid = tid >> 6, lane = tid & 63, r32 = lane & 31, hi = lane >> 5;
  bf16_t* Ow = Ob + (long)(wid * 32 + (lane >> 3)) * ldo + (lane & 7) * 8;
#pragma unroll
  for (int h2 = 0; h2 < 2; ++h2) {
#pragma unroll
    for (int dd = 0; dd < 2; ++dd)
#pragma unroll
      for (int r = 0; r < 16; ++r) *(bf16_t*)(wl + crow(r, hi) * 128 + (dd * 32 + r32) * 2) = f2bf(o[h2 * 2 + dd][r]);
#pragma unroll
    for (int k = 0; k < 4; ++k) { const u32x4 v = *(const u32x4*)(wl + (k * 8 + (lane >> 3)) * 128 + (lane & 7) * 16); *(u32x4*)(Ow + (long)(k * 8) * ldo + h2 * 64) = v; }
  }
}
}

__device__ __forceinline__ float wave_sum(float v) {
#pragma unroll
  for (int o = 32; o >= 1; o >>= 1) v += __shfl_xor(v, o);
  return v;
}
enum { PM_ID = 0, PM_IN, PM_UQ, PM_GU };
__device__ __forceinline__ int perm_n0(int type, int p0, int& use1) {
  use1 = 0;
  if (type == PM_IN) {
    if (p0 < 768) return p0;
    if (p0 < 1024) { const int q = p0 - 768; return (q == 0) ? 768 : (q == 128 ? 800 : -1); }
    if (p0 < 3072) { const int tt = p0 - 1024, tile = tt >> 8, q = tt & 255, half = q >> 7, sub = (q >> 6) & 1, i = q & 63; return 832 + tile * 256 + sub * 128 + half * 64 + i; }
    return 2880 + (p0 - 3072);
  } else if (type == PM_UQ) {
    if (p0 < 1024) return (p0 >> 7) * 192 + (p0 & 127);
    const int tt = p0 - 1024, tile = tt >> 8, q = tt & 255, half = q >> 7, hh = (q >> 5) & 3; return (4 * tile + hh) * 192 + 128 + 32 * half;
  } else if (type == PM_GU) {
    const int tile = p0 >> 8, q = p0 & 255; if (q < 128) return tile * 128 + q; use1 = 1; return tile * 128 + q - 128;
  }
  return p0;
}
__device__ __forceinline__ void transpose_w(const float* __restrict__ src0, const float* __restrict__ src1, int K, int N, bf16_t* __restrict__ dst, int P, int type, float* tl, int first, int stride) {
  const int tid = threadIdx.x, nkt = K / 128, ntiles = nkt * (P / 64), c32 = tid & 31, kq = tid >> 5;
  for (int t = first; t < ntiles; t += stride) {
    const int pi = t / nkt, ki = t - pi * nkt, p0 = pi * 64, k0 = ki * 128;
    int u0, u1; const int n0a = perm_n0(type, p0, u0), n0b = perm_n0(type, p0 + 32, u1);
    const float* sa = (u0 ? src1 : src0) + (size_t)k0 * N + (n0a < 0 ? 0 : n0a) + c32; const float* sb = (u1 ? src1 : src0) + (size_t)k0 * N + (n0b < 0 ? 0 : n0b) + c32;
    float va[8], vb[8];
#pragma unroll
    for (int i = 0; i < 8; ++i) { va[i] = sa[(size_t)(kq + 16 * i) * N]; vb[i] = sb[(size_t)(kq + 16 * i) * N]; }
    __syncthreads();
#pragma unroll
    for (int i = 0; i < 8; ++i) { tl[(kq + 16 * i) * 33 + c32] = n0a < 0 ? 0.f : va[i]; tl[128 * 33 + (kq + 16 * i) * 33 + c32] = n0b < 0 ? 0.f : vb[i]; }
    __syncthreads();
    const int row = tid >> 4, kc = (tid & 15) * 8;
#pragma unroll
    for (int h = 0; h < 2; ++h) { const float* q = tl + h * 128 * 33 + kc * 33 + row;
      u32x4 w; w.x = cvt_pk_bf16(q[0], q[33]); w.y = cvt_pk_bf16(q[66], q[99]); w.z = cvt_pk_bf16(q[132], q[165]); w.w = cvt_pk_bf16(q[198], q[231]);
      *(u32x4*)(dst + (size_t)(p0 + h * 32 + row) * K + k0 + kc) = w; }
  }
}
__device__ __forceinline__ void rownorm_bf16(const float* __restrict__ x, const float* __restrict__ g, bf16_t* __restrict__ out, int nrows) {
  const int wave = threadIdx.x >> 6, lane = threadIdx.x & 63;
  for (int row = blockIdx.x * 8 + wave; row < nrows; row += gridDim.x * 8) {
    const f32x4* xr = (const f32x4*)(x + (size_t)row * DM); f32x4 v[8]; float ss = 0.f;
#pragma unroll
    for (int j = 0; j < 8; ++j) { v[j] = xr[lane + 64 * j]; ss += dot4(v[j]); }
    ss = wave_sum(ss); const float r = rsqrtf(ss * (1.f / DM) + NORM_EPS);
#pragma unroll
    for (int j = 0; j < 8; ++j) { const f32x4 gv = ((const f32x4*)g)[lane + 64 * j], w = v[j] * gv * r; u32x2 pk; pk.x = cvt_pk_bf16(w[0], w[1]); pk.y = cvt_pk_bf16(w[2], w[3]);
      *(u32x2*)(out + (size_t)row * DM + 4 * (lane + 64 * j)) = pk; }
  }
}

#define XB_TMO      128
#define XB_XCNT(j)  (256  + 64 * (j))
#define XB_XSUB(j)  (1280 + 64 * (j))
#define XB_XGEN(j)  (2304 + 64 * (j))
#define XB_TOP      3328
#define XB_TOPGEN   3392
#define XCD_BAR_WORDS 3456
#define XB_SPIN_CAP (1u << 18)

__device__ __forceinline__ unsigned xb_ld(unsigned* p)              { return __hip_atomic_load(p, __ATOMIC_RELAXED, __HIP_MEMORY_SCOPE_AGENT); }
__device__ __forceinline__ unsigned xb_add(unsigned* p, unsigned v) { return __hip_atomic_fetch_add(p, v, __ATOMIC_RELAXED, __HIP_MEMORY_SCOPE_AGENT); }
__device__ __forceinline__ unsigned xb_xcc_id() { return (unsigned)__builtin_amdgcn_s_getreg((3 << 11) | 20) & 0xFu; }
#define XB_SPIN(cond, bar) do { unsigned _sp = 0; while (cond) { __builtin_amdgcn_s_sleep(1); \
    if ((++_sp & 255u) == 0u) { if (xb_ld(&(bar)[XB_TMO])) break; if (_sp > XB_SPIN_CAP) { atomicAdd(&(bar)[XB_TMO], 1u); break; } } } } while (0)

struct XcdBarrier {
    unsigned* bar; unsigned x;
    volatile LAS unsigned* st;
};

__device__ __forceinline__ XcdBarrier xcd_barrier_post(unsigned* bar, volatile LAS unsigned* st) {
    XcdBarrier b; b.bar = bar; b.x = xb_xcc_id(); b.st = st;
    if (threadIdx.x == 0) (void)xb_add(&bar[XB_XCNT(b.x)], 1u);
    return b;
}
__device__ __forceinline__ void xcd_barrier_complete(unsigned* bar, unsigned x, unsigned& nloc, unsigned& nx) {
    const unsigned G = gridDim.x * gridDim.y * gridDim.z;
    unsigned sum, cnt, mine, sp = 0u;
    for (;;) {
        sum = 0u; cnt = 0u; mine = 0u;
#pragma unroll
        for (unsigned j = 0; j < 16; ++j) { const unsigned c = xb_ld(&bar[XB_XCNT(j)]); sum += c; cnt += (c > 0u) ? 1u : 0u; mine = (j == x) ? c : mine; }
        if (sum == G) break;
        __builtin_amdgcn_s_sleep(1);
        if ((++sp & 255u) == 0u) { if (xb_ld(&bar[XB_TMO])) break; if (sp > XB_SPIN_CAP) { atomicAdd(&bar[XB_TMO], 1u); break; } }
    }
    nloc = mine > 0u ? mine : 1u; nx = cnt > 0u ? cnt : 1u;
}

__device__ __forceinline__ void xcd_barrier(const XcdBarrier& b) {
    asm volatile("s_waitcnt vmcnt(0)" ::: "memory");
    __syncthreads();
    if (threadIdx.x == 0) {
        unsigned* bar = b.bar;
        __builtin_amdgcn_s_waitcnt(0);
        unsigned nloc = b.st[0], nx = b.st[1];
        if (nloc == 0u) { xcd_barrier_complete(bar, b.x, nloc, nx); b.st[0] = nloc; b.st[1] = nx; }
        const unsigned old = xb_add(&bar[XB_XSUB(b.x)], 1u);
        const unsigned gen = old / nloc;
        if (old + 1u == (gen + 1u) * nloc) {
            __builtin_amdgcn_fence(__ATOMIC_RELEASE, "agent");
            asm volatile("s_waitcnt vmcnt(0)" ::: "memory");
            const unsigned og = xb_add(&bar[XB_TOP], 1u);
            const unsigned tg = og / nx;
            if (og + 1u == (tg + 1u) * nx) xb_add(&bar[XB_TOPGEN], 1u);
            else XB_SPIN(xb_ld(&bar[XB_TOPGEN]) == tg, bar);
            __builtin_amdgcn_fence(__ATOMIC_ACQUIRE, "agent");
            xb_add(&bar[XB_XGEN(b.x)], 1u);
            asm volatile("s_waitcnt vmcnt(0)" ::: "memory");
        } else {
            XB_SPIN(xb_ld(&bar[XB_XGEN(b.x)]) == gen, bar);
            __builtin_amdgcn_fence(__ATOMIC_ACQUIRE, "agent");
            asm volatile("s_waitcnt vmcnt(0)" ::: "memory");
        }
    }
    __syncthreads();
}


constexpr int LDS_BYTES = at::LDS_PAIR;
static_assert(at::LDS_ATTN <= LDS_BYTES && at::LDS_ROT <= LDS_BYTES && pg8::STAGE_BYTES <= LDS_BYTES && LDS_BYTES % 16 == 0 && LDS_BYTES + 16 <= 163840, "LDS budget");
constexpr int LDS_TOTAL = LDS_BYTES + 16;
constexpr size_t O_CNT = O_SS + 344064 + 16384;
constexpr size_t O_BAR = O_SS + 344064;
static_assert(O_BAR + XCD_BAR_WORDS * 4 <= O_A && (size_t)(5 * T + 1) * 4 <= 344064, "barrier words fit");

__global__ void __launch_bounds__(512, 2) fwd_megakernel(const Params p) {
  extern __shared__ __attribute__((aligned(16))) unsigned char shm[];
  cg::grid_group grid = cg::this_grid();
  const int G = gridDim.x, bid = blockIdx.x, tid = threadIdx.x;
  unsigned char* ws = p.ws;
  float* ssb = (float*)(ws + O_SS);
  float* cos_d = (float*)(ws + O_COSD); float* sin_d = (float*)(ws + O_SIND); float* cos_r = (float*)(ws + O_COSR); float* sin_r = (float*)(ws + O_SINR);
  LAS unsigned char* lds = (LAS unsigned char*)shm;
  unsigned* barw = (unsigned*)(ws + O_BAR); volatile LAS unsigned* xst = (volatile LAS unsigned*)(lds + LDS_BYTES);
  if (tid < 4) xst[tid] = 0u;
  __syncthreads();
  (void)xcd_barrier_post(barw, xst);
  if (p.ph_lo < 0) grid.sync();
#ifndef PHMASK
#define PHMASK 0x7ff
#endif
#define IN(k) (((PHMASK >> (k)) & 1) && p.ph_lo <= (k) && (k) < p.ph_hi)
#ifndef DUPMASK
#define DUPMASK 0
#endif
#define SEAM(k) do { XcdBarrier xb_; xb_.bar = barw; xb_.x = xb_xcc_id(); xb_.st = xst; xcd_barrier(xb_); } while (0)
#define REP(k) for (int rep_ = 0; rep_ < 1 + ((DUPMASK >> (k)) & 1); ++rep_, ((DUPMASK >> (k)) & 1) ? grid.sync() : (void)0)

  if (IN(0)) REP(0) {
    float* tl = (float*)shm;
    transpose_w(p.in[I_WIN], nullptr, DM, IN_W, (bf16_t*)(ws + O_WIN), IN_P, PM_IN, tl, bid, G);
    transpose_w(p.in[I_WUQ], nullptr, 512, 1536, (bf16_t*)(ws + O_WUQ), 1536, PM_UQ, tl, bid, G);
    transpose_w(p.in[I_WUKV], nullptr, 256, 2048, (bf16_t*)(ws + O_WUKV), 2048, PM_ID, tl, bid, G);
    if (G != 256) transpose_w(p.in[I_WOUT], nullptr, DM, DM, (bf16_t*)(ws + O_WOUT), DM, PM_ID, tl, bid, G);
    if (G != 256) transpose_w(p.in[I_WXQ], nullptr, DM, 512, (bf16_t*)(ws + O_WXQ), 512, PM_ID, tl, bid, G);
    transpose_w(p.in[I_WXK], nullptr, DM, 512, (bf16_t*)(ws + O_WXKV), 512, PM_ID, tl, bid, G);
    transpose_w(p.in[I_WXV], nullptr, DM, 512, (bf16_t*)(ws + O_WXKV) + (size_t)512 * DM, 512, PM_ID, tl, bid, G);
    if (G != 256) transpose_w(p.in[I_WXO], nullptr, 512, DM, (bf16_t*)(ws + O_WXO), DM, PM_ID, tl, bid, G);
    transpose_w(p.in[I_WGATE], p.in[I_WUP], DM, FFN, (bf16_t*)(ws + O_WGU), 2 * FFN, PM_GU, tl, bid, G);
    if (G != 256) transpose_w(p.in[I_WDOWN], nullptr, FFN, DM, (bf16_t*)(ws + O_WDN), DM, PM_ID, tl, bid, G);
    rownorm_bf16(p.in[I_X], p.in[I_GMIX], (bf16_t*)(ws + O_H), T);
    rownorm_bf16(p.in[I_MEM], p.in[I_GMEM], (bf16_t*)(ws + O_HM), NB * MEMT);
    for (int i = bid * 512 + tid; i < 5 * T; i += G * 512) ssb[i] = 0.f;
    const int* pos = (const int*)p.in[I_POS];
    for (int i = bid * 512 + tid; i < T * 64; i += G * 512) { const int t = i >> 6, f = i & 63;
      const double rev = (double)pos[t] * INVF_D[f] * 0.15915494309189535; const float fr = (float)(rev - __builtin_rint(rev));
      cos_d[i] = __builtin_amdgcn_cosf(fr); sin_d[i] = __builtin_amdgcn_sinf(fr);
      if ((f & 1) == 0) { cos_r[t * 32 + (f >> 1)] = __builtin_amdgcn_cosf(fr); sin_r[t * 32 + (f >> 1)] = __builtin_amdgcn_sinf(fr); } }
    if (bid == 0 && tid < 64) {
      const float a = p.in[I_LQ1][tid] * p.in[I_LK1][tid] + p.in[I_LQ1][tid + 64] * p.in[I_LK1][tid + 64];
      const float b = p.in[I_LQ2][tid] * p.in[I_LK2][tid] + p.in[I_LQ2][tid + 64] * p.in[I_LK2][tid + 64];
      const float sa = wave_sum(a), sb = wave_sum(b);
      if (tid == 0) ssb[SS_LAM] = __expf(sa) - __expf(sb) + 0.2f;
    }
    __syncthreads();
  }
  SEAM(0);

  if (IN(1)) {
    pg8::Gemm g{(const bf16_t*)(ws + O_H), (const bf16_t*)(ws + O_WIN), T, IN_P, DM}; pg8::StaticOrder S; S.init(T, IN_P, G, bid);
    EpiProj E{(bf16_t*)(ws + O_CQ), (bf16_t*)(ws + O_CKV), (bf16_t*)(ws + O_KR), (bf16_t*)(ws + O_DQ), (bf16_t*)(ws + O_DK), (bf16_t*)(ws + O_DV), ssb + SS_CQ, ssb + SS_CKV,
              p.in[I_GQLAT], p.in[I_GKVLAT], cos_d, sin_d, cos_r, sin_r};
    pg8::gemm_phase(lds, g, S, E);
  }
  SEAM(1);

  if (IN(2)) {
#ifndef NO_Q
    { pg8::Gemm g{(const bf16_t*)(ws + O_CQ), (const bf16_t*)(ws + O_WUQ), T, 1536, 512}; pg8::StaticOrder S; S.init(T, 1536, G, bid);
      EpiQ E{(bf16_t*)(ws + O_QN), (bf16_t*)(ws + O_QR), ssb + SS_CQ, cos_r, sin_r};
      pg8::gemm_phase(lds, g, S, E); }
#endif
#ifndef NO_KV
    { pg8::Gemm g{(const bf16_t*)(ws + O_CKV), (const bf16_t*)(ws + O_WUKV), T, 2048, 256}; pg8::StaticOrder S; S.init(T, 2048, G, G - 1 - bid);
      EpiKV E{(bf16_t*)(ws + O_KN), (bf16_t*)(ws + O_VM), ssb + SS_CKV};
      pg8::gemm_phase(lds, g, S, E); }
#endif
    if (G == 256 && bid >= 128) {
      float* tl = (float*)shm;
      transpose_w(p.in[I_WOUT], nullptr, DM, DM, (bf16_t*)(ws + O_WOUT), DM, PM_ID, tl, bid - 128, 128);
      transpose_w(p.in[I_WXQ], nullptr, DM, 512, (bf16_t*)(ws + O_WXQ), 512, PM_ID, tl, bid - 128, 128); }
  }
  SEAM(2);

  if (IN(3)) {
    const int wid = tid >> 6, lane = tid & 63, r32 = lane & 31, hi = lane >> 5;
    const float LOG2E = 1.4426950408889634f;
#ifndef NO_DIFF
    for (int it = 0; bid + (it >> 2) * G < 256 * (1 + ((DUPMASK >> 3) & 1)); ++it) {
      const int pass = it & 3, hb = pass >> 1, u = (bid + (it >> 2) * G) & 255, x = u & 7, y = u >> 3, qb = y & 7, bh = (y >> 3) * 8 + x, b = bh >> 2, h = bh & 3;
      const size_t rowq = (size_t)b * SEQ + qb * 256, rowk = (size_t)b * SEQ;
      const int qsel = (pass & 1) ? 0 : 128;
      const bf16_t* dq = (const bf16_t*)(ws + O_DQ) + (rowq + hb * 128) * 1024 + h * 256 + qsel; const bf16_t* dk = (const bf16_t*)(ws + O_DK) + rowk * 1024 + h * 256 + qsel;
      const bf16_t* dv = (const bf16_t*)(ws + O_DV) + rowk * 1024 + h * 256;
      f32x4* sl = (f32x4*)(ws + O_SCR) + ((size_t)(u * 16 + (hb * 2 + (wid >> 2)) * 4 + (wid & 3)) * 1024 + lane);
      const float lam = ssb[SS_LAM]; const float C = 0.08838834764831845f * LOG2E, thr = 8.f / 0.08838834764831845f;
      f32x16 o[4];
      at::attn_core_pair(o, dq, dk, dv, SEQ, C, thr, (char*)shm);
#define O4(d, q) (f32x4){o[d][4 * (q)], o[d][4 * (q) + 1], o[d][4 * (q) + 2], o[d][4 * (q) + 3]}
      f32x4* sl8 = sl + 8 * 64;
      if ((pass & 1) == 0) {
#pragma unroll
        for (int d = 0; d < 4; ++d)
#pragma unroll
          for (int q = 0; q < 4; q += 2) sl8[(d * 2 + (q >> 1)) * 64] = __builtin_bit_cast(f32x4, pack8(O4(d, q), O4(d, q + 1)));
      } else {
#pragma unroll
        for (int d = 0; d < 4; ++d) {
#pragma unroll
          for (int q = 0; q < 4; q += 2) { const u32x4 w = __builtin_bit_cast(u32x4, sl8[(d * 2 + (q >> 1)) * 64]);
            const f32x4 a = {__uint_as_float(w.x << 16), __uint_as_float(w.x & 0xffff0000u), __uint_as_float(w.y << 16), __uint_as_float(w.y & 0xffff0000u)};
            const f32x4 b = {__uint_as_float(w.z << 16), __uint_as_float(w.z & 0xffff0000u), __uint_as_float(w.w << 16), __uint_as_float(w.w & 0xffff0000u)};
            sl[(d * 4 + q) * 64] = O4(d, q) - lam * a; sl[(d * 4 + q + 1) * 64] = O4(d, q + 1) - lam * b; }
          EPI_FENCE(); }
      }
#undef O4
    }
    __syncthreads();
    for (int u = bid; u < 256; u += G) {
      const int x = u & 7, y = u >> 3, qb = y & 7, bh = (y >> 3) * 8 + x, b = bh >> 2, h = bh & 3;
      const size_t rowq = (size_t)b * SEQ + qb * 256;
      const f32x4* scr = (const f32x4*)(ws + O_SCR) + ((size_t)(u * 16 + (wid >> 2) * 8 + (wid & 3)) * 1024 + lane);
      { float ssq[16];
#pragma unroll
        for (int r = 0; r < 16; ++r) ssq[r] = 0.f;
#pragma unroll 1
        for (int d = 0; d < 4; ++d) {
#pragma unroll
          for (int q = 0; q < 4; ++q) { const f32x4 lo = scr[(d * 4 + q) * 64], hv = scr[4 * 1024 + (d * 4 + q) * 64];
#pragma unroll
            for (int j = 0; j < 4; ++j) ssq[4 * q + j] += lo[j] * lo[j] + hv[j] * hv[j]; }
          EPI_FENCE(); }
#pragma unroll
        for (int r = 0; r < 16; ++r) {
#pragma unroll
          for (int s = 16; s >= 1; s >>= 1) ssq[r] += __shfl_xor(ssq[r], s);
          ssq[r] = rsqrtf(ssq[r] * (1.f / 256.f) + 1e-5f) * 0.8f; }
        const float* gd = p.in[I_GDIFF];
        char* wl = (char*)shm + wid * 16384;
#pragma unroll 1
        for (int d = 0; d < 4; ++d) { const float glo = gd[d * 32 + r32], ghi = gd[128 + d * 32 + r32];
#pragma unroll
          for (int q = 0; q < 4; ++q) { const f32x4 lo = scr[(d * 4 + q) * 64], hv = scr[4 * 1024 + (d * 4 + q) * 64];
#pragma unroll
            for (int j = 0; j < 4; ++j) { const int r = 4 * q + j; bf16_t* lp = (bf16_t*)(wl + (j + 8 * q + 4 * hi) * 512) + d * 32 + r32;
              lp[0] = f2bf(lo[j] * ssq[r] * glo); lp[128] = f2bf(hv[j] * ssq[r] * ghi); } }
          EPI_FENCE(); }
        bf16_t* Ow = (bf16_t*)(ws + O_ATT) + (rowq + wid * 32 + (lane >> 5)) * 2048 + 1024 + h * 256 + (lane & 31) * 8;
#pragma unroll
        for (int k = 0; k < 16; ++k) { const u32x4 v = *(const u32x4*)(wl + (k * 2 + (lane >> 5)) * 512 + (lane & 31) * 16); *(u32x4*)(Ow + (size_t)(k * 2) * 2048) = v; }
      }
    }
    __syncthreads();
#endif
#ifndef NO_MLA
    for (int uu = bid; uu < 512 * (1 + ((DUPMASK >> 3) & 1)); uu += G) {
      const int u = uu & 511, x = u & 7, y = u >> 3, qb = y & 7, bh = (y >> 3) * 8 + x, b = bh >> 3, h = bh & 7;
      const size_t rowq = (size_t)b * SEQ + qb * 256, rowk = (size_t)b * SEQ;
      const float sc = 0.07216878364870322f;
      f32x16 o[4];
      at::attn_core_rot<12, 1024, 512>(o, (const bf16_t*)(ws + O_QN) + rowq * 1024 + h * 128, (const bf16_t*)(ws + O_QR) + rowq * 512 + h * 64,
                                   (const bf16_t*)(ws + O_KN) + rowk * 1024 + h * 128, (const bf16_t*)(ws + O_KR) + rowk * 64, (const bf16_t*)(ws + O_VM) + rowk * 1024 + h * 128,
                                   SEQ, sc * LOG2E, 8.f / sc, (char*)shm);
      at::store_o_bf16_lds(o, (bf16_t*)(ws + O_ATT) + rowq * 2048 + h * 128, 2048, (char*)shm + at::R_QR + (tid >> 6) * 4096);
    }
#endif
  }
  SEAM(3);

  if (IN(4)) {
    pg8::Gemm g{(const bf16_t*)(ws + O_ATT), (const bf16_t*)(ws + O_WOUT), T, DM, DM}; pg8::StaticOrder S; S.init(T, DM, G, bid);
    EpiRes E{p.in[I_X], p.out, (bf16_t*)(ws + O_X1B), p.in[I_GXATTN], ssb + SS_X1};
    pg8::gemm_phase(lds, g, S, E);
  }
  SEAM(4);

  if (IN(5)) {
    { pg8::Gemm g{(const bf16_t*)(ws + O_X1B), (const bf16_t*)(ws + O_WXQ), T, 512, DM}; pg8::StaticOrder S; S.init(T, 512, G, bid);
      EpiScale E{(bf16_t*)(ws + O_XQ), 512, ssb + SS_X1, 1.f / 2048.f};
      pg8::gemm_phase(lds, g, S, E); }
    { pg8::Gemm g{(const bf16_t*)(ws + O_HM), (const bf16_t*)(ws + O_WXKV), NB * MEMT, 1024, DM}; pg8::StaticOrder S; S.init(NB * MEMT, 1024, G, G - 1 - bid);
      EpiScale E{(bf16_t*)(ws + O_XKV), 1024, nullptr, 0.f};
      pg8::gemm_phase(lds, g, S, E); }
    if (G == 256 && bid >= 128 && bid < 224) {
      float* tl = (float*)shm;
      transpose_w(p.in[I_WXO], nullptr, 512, DM, (bf16_t*)(ws + O_WXO), DM, PM_ID, tl, bid - 128, 96);
      transpose_w(p.in[I_WDOWN], nullptr, FFN, DM, (bf16_t*)(ws + O_WDN), DM, PM_ID, tl, bid - 128, 96); }
  }
  SEAM(5);

  if (IN(6)) {
    for (int u = bid; u < 256; u += G) {
      const int h = u & 3, rb = u >> 2, b = rb >> 3; const size_t rowq = (size_t)rb * 256, rowk = (size_t)b * MEMT;
      const float sc = 0.08838834764831845f; f32x16 o[4];
      at::attn_core<8, 512, 64, 2, 8>(o, (const bf16_t*)(ws + O_XQ) + rowq * 512 + h * 128, nullptr, (const bf16_t*)(ws + O_XKV) + rowk * 1024 + h * 128, nullptr,
                                (const bf16_t*)(ws + O_XKV) + rowk * 1024 + 512 + h * 128, MEMT, sc * 1.4426950408889634f, 8.f / sc, (char*)shm);
      at::store_o_bf16_lds(o, (bf16_t*)(ws + O_XO) + rowq * 512 + h * 128, 512, (char*)shm + at::OFF_QR + (tid >> 6) * 8192);
    }
  }
  SEAM(6);

  if (IN(7)) {
    pg8::Gemm g{(const bf16_t*)(ws + O_XO), (const bf16_t*)(ws + O_WXO), T, DM, 512}; pg8::StaticOrder S; S.init(T, DM, G, bid);
    EpiRes E{p.out, p.out, (bf16_t*)(ws + O_X2B), p.in[I_GFFN], ssb + SS_X2};
    pg8::gemm_phase(lds, g, S, E);
  }
  SEAM(7);

  if (IN(8)) REP(8) {
    pg8::Gemm g{(const bf16_t*)(ws + O_X2B), (const bf16_t*)(ws + O_WGU), T, 2 * FFN, DM}; pg8::StaticOrder S; S.init(T, 2 * FFN, G, bid);
    EpiSwiGLU E{(bf16_t*)(ws + O_HID), ssb + SS_X2};
    pg8::gemm_phase(lds, g, S, E);
  }
  SEAM(8);

  if (IN(9)) {
    pg8::Gemm g{(const bf16_t*)(ws + O_HID), (const bf16_t*)(ws + O_WDN), T, DM, FFN}; pg8::StaticOrder S; S.init(T, DM, G, bid);
    if (G == 256) { S.panel = 1; EpiFinal E{p.out, p.in[I_GFINAL], ssb + SS_X3, (unsigned*)(ws + O_CNT)};
      for (int rnd = 0; rnd < 2; ++rnd) { S.only = rnd; pg8::gemm_phase(lds, g, S, E); } }
    else { EpiRes E{p.out, p.out, nullptr, nullptr, ssb + SS_X3}; pg8::gemm_phase(lds, g, S, E); }
  }
  if (G != 256) {
    SEAM(9);
    const int wave = tid >> 6, lane = tid & 63; const float* gf = p.in[I_GFINAL];
    for (int row = bid * 8 + wave; row < T; row += G * 8) {
      const float r = rsqrtf(ssb[SS_X3 + row] * (1.f / DM) + NORM_EPS); f32x4* xr = (f32x4*)(p.out + (size_t)row * DM);
#pragma unroll
      for (int j = 0; j < 8; ++j) { const f32x4 gv = ((const f32x4*)gf)[lane + 64 * j]; xr[lane + 64 * j] = xr[lane + 64 * j] * gv * r; }
    }
  }
#undef IN
#undef SEAM
}

extern "C" void kernel_launch(void* const* d_in, const int* in_sizes, int n_in, void* d_out, int out_size, void* d_ws, size_t ws_size, hipStream_t stream) {
  static int grid_blocks = 0;
  if (grid_blocks == 0) {
    if (n_in != 26 || out_size != T * DM || ws_size < WS_END) { fprintf(stderr, "kernel_launch: unexpected shapes n_in %d out %d ws %zu (need %zu)\n", n_in, out_size, ws_size, (size_t)WS_END); grid_blocks = -1; return; }
    int dev = 0, cus = 0, per_cu = 0;
    hipGetDevice(&dev); hipDeviceGetAttribute(&cus, hipDeviceAttributeMultiprocessorCount, dev);
    if (hipFuncSetAttribute((const void*)fwd_megakernel, hipFuncAttributeMaxDynamicSharedMemorySize, LDS_TOTAL) != hipSuccess) { fprintf(stderr, "kernel_launch: hipFuncSetAttribute failed\n"); grid_blocks = -1; return; }
    if (hipOccupancyMaxActiveBlocksPerMultiprocessor(&per_cu, (const void*)fwd_megakernel, 512, LDS_TOTAL) != hipSuccess || per_cu < 1) { fprintf(stderr, "kernel_launch: occupancy query failed (%d)\n", per_cu); per_cu = 1; }
    (void)hipGetLastError();
    grid_blocks = cus * 1;
    fprintf(stderr, "kernel_launch: cus %d per_cu %d grid %d\n", cus, per_cu, grid_blocks);
  }
  if (grid_blocks < 0) return;
  if (hipMemsetAsync((char*)d_ws + O_BAR, 0, 32768, stream) != hipSuccess) { fprintf(stderr, "kernel_launch: hipMemsetAsync failed\n"); return; }
  Params p{};
  for (int i = 0; i < 26; ++i) p.in[i] = (const float*)d_in[i];
  p.out = (float*)d_out; p.ws = (unsigned char*)d_ws; p.ph_lo = 0; p.ph_hi = 11;
  void* args[] = {&p};
  hipError_t e = hipLaunchCooperativeKernel((const void*)fwd_megakernel, dim3(grid_blocks), dim3(512), args, LDS_TOTAL, stream);
  if (e != hipSuccess) fprintf(stderr, "kernel_launch: cooperative launch failed: %s (grid %d)\n", hipGetErrorString(e), grid_blocks);
}
```

```cpp
#include <hip/hip_runtime.h>
#include <hip/hip_bf16.h>
#include <hip/hip_cooperative_groups.h>
#include <cstdio>
namespace cg = cooperative_groups;

typedef unsigned short bf16_t;
typedef short bf16x8 __attribute__((ext_vector_type(8)));
typedef short s16x4 __attribute__((ext_vector_type(4)));
typedef float f32x4 __attribute__((ext_vector_type(4)));
typedef float f32x16 __attribute__((ext_vector_type(16)));
typedef unsigned u32x4 __attribute__((ext_vector_type(4)));
typedef unsigned u32x2 __attribute__((ext_vector_type(2)));
#define LAS __attribute__((address_space(3)))

constexpr int T = 16384, DM = 2048, SEQ = 2048, MEMT = 256, NB = 8;
constexpr int IN_W = 3904, IN_P = 4096, FFN = 5632;
constexpr float NORM_EPS = 1e-6f;

constexpr size_t MiB = (size_t)1 << 20;
constexpr size_t O_WIN = 0, O_WUQ = 16 * MiB, O_WUKV = O_WUQ + 3 * MiB / 2, O_WOUT = O_WUKV + 1 * MiB, O_WXQ = O_WOUT + 8 * MiB, O_WXKV = O_WXQ + 2 * MiB,
                 O_WXO = O_WXKV + 4 * MiB, O_WGU = O_WXO + 2 * MiB, O_WDN = O_WGU + 44 * MiB, O_COSD = O_WDN + 22 * MiB, O_SIND = O_COSD + 4 * MiB,
                 O_COSR = O_SIND + 4 * MiB, O_SINR = O_COSR + 2 * MiB, O_SS = O_SINR + 2 * MiB, O_A = O_SS + MiB / 2;
constexpr size_t O_H = O_A, O_CQ = O_H + 64 * MiB, O_CKV = O_CQ + 16 * MiB, O_KR = O_CKV + 8 * MiB, O_DQ = O_KR + 2 * MiB, O_DK = O_DQ + 32 * MiB, O_DV = O_DK + 32 * MiB,
                 O_B = O_DV + 32 * MiB, O_HID = O_A, O_SCR = O_H;
constexpr size_t O_HM = O_B, O_QN = O_HM + 8 * MiB, O_KN = O_QN + 32 * MiB, O_QR = O_KN + 32 * MiB, O_VM = O_QR + 16 * MiB, O_ATT = O_VM + 32 * MiB, O_XKV = O_ATT + 64 * MiB,
                 WS_END = O_XKV + 4 * MiB, O_X1B = O_QN, O_X2B = O_ATT, O_XQ = O_QR, O_XO = O_VM;
static_assert(O_HID + (size_t)T * FFN * 2 <= O_B, "hidden fits region A");
constexpr int SS_CQ = 0, SS_CKV = T, SS_X1 = 2 * T, SS_X2 = 3 * T, SS_X3 = 4 * T, SS_LAM = 5 * T;

__device__ const double INVF_D[64] = {1, 0.86596432336006535, 0.74989420933245587, 0.64938163157621132, 0.56234132519034907, 0.48696752516586311, 0.42169650342858223, 0.36517412725483772, 0.31622776601683794, 0.27384196342643613, 0.23713737056616552, 0.20535250264571461, 0.17782794100389229, 0.15399265260594919, 0.1333521432163324, 0.11547819846894582, 0.10000000000000001, 0.086596432336006529, 0.074989420933245579, 0.064938163157621132, 0.056234132519034911, 0.048696752516586311, 0.042169650342858224, 0.036517412725483769, 0.031622776601683791, 0.027384196342643614, 0.023713737056616554, 0.02053525026457146, 0.017782794100389229, 0.015399265260594919, 0.013335214321633241, 0.011547819846894581, 0.01, 0.0086596432336006543, 0.0074989420933245579, 0.006493816315762113, 0.005623413251903491, 0.004869675251658631, 0.0042169650342858229, 0.0036517412725483771, 0.0031622776601683794, 0.0027384196342643613, 0.0023713737056616554, 0.002053525026457146, 0.0017782794100389228, 0.001539926526059492, 0.0013335214321633241, 0.0011547819846894581, 0.001, 0.00086596432336006539, 0.00074989420933245586, 0.00064938163157621134, 0.0005623413251903491, 0.0004869675251658631, 0.00042169650342858224, 0.0003651741272548377, 0.00031622776601683794, 0.00027384196342643611, 0.00023713737056616554, 0.00020535250264571461, 0.00017782794100389227, 0.00015399265260594919, 0.0001333521432163324, 0.00011547819846894582};

struct Params {
  const float* in[26];
  float* out;
  unsigned char* ws;
  int ph_lo, ph_hi;
};
enum { I_X = 0, I_MEM, I_POS, I_GMIX, I_WIN, I_GQLAT, I_WUQ, I_GKVLAT, I_WUKV, I_LQ1, I_LK1, I_LQ2, I_LK2, I_GDIFF, I_WOUT, I_GXATTN, I_GMEM, I_WXQ, I_WXK, I_WXV, I_WXO,
       I_GFFN, I_WGATE, I_WUP, I_WDOWN, I_GFINAL };

__device__ __forceinline__ unsigned cvt_pk_bf16(float lo, float hi) { unsigned r; asm volatile("v_cvt_pk_bf16_f32 %0, %1, %2" : "=v"(r) : "v"(lo), "v"(hi)); return r; }
__device__ __forceinline__ bf16_t f2bf(float f) { return (bf16_t)(cvt_pk_bf16(f, 0.f) & 0xffffu); }

namespace pg8 {
constexpr int BM = 256, BK = 64, HALF = 128, HTB = HALF * BK * 2, STAGE_BYTES = 8 * HTB, NXCD = 8, WGM = 8;
__host__ __device__ __forceinline__ int lds_byte(int r, int c) { const int st = (r >> 4) * 2 + (c >> 5), rr = r & 15, cc = c & 31, ob = rr * 64 + cc * 2; return st * 1024 + (ob ^ (((ob >> 9) & 1) << 5)); }
__host__ __device__ __forceinline__ void stage_rc(int b, int& R, int& C) { const int st = b / 1024, sb = b % 1024, swz = sb ^ (((sb >> 9) & 1) << 5); R = (st >> 1) * 16 + swz / 64; C = (st & 1) * 32 + (swz % 64) / 2; }
__host__ __device__ __forceinline__ int perm32(int rho) { const int n = rho >> 4, i = rho & 15; return 8 * (i >> 2) + 4 * n + (i & 3); }
struct Unit { int pm, pn; };
struct Gemm { const bf16_t* A; const bf16_t* Bt; int M, N, K; };
struct StaticOrder {
  int nM, nN, nwg, G, c, panel, only;
  __host__ __device__ void init(int M, int N, int G_, int c_) { nM = M / BM; nN = N / BM; nwg = nM * nN; G = G_; c = c_; panel = 0; only = -1; }
  __host__ __device__ bool next(int i, Unit& u) const {
    if (only >= 0) { if (i != 0) return false; i = only; }
    const long L = (long)i * G + c; if (L >= nwg) return false;
    if (panel) { const int x = c & 7, j = c >> 3; u.pm = x * 8 + i * 4 + (j >> 3); u.pn = j & 7; return true; }
    int wgid = (int)L; { const int q = nwg / NXCD, r = nwg % NXCD, xcd = wgid % NXCD, off = wgid / NXCD; wgid = (xcd < r ? xcd * (q + 1) : r * (q + 1) + (xcd - r) * q) + off; }
    const int nig = WGM * nN, gid = wgid / nig, fm = gid * WGM, gsz = (nM - fm) < WGM ? (nM - fm) : WGM;
    u.pm = fm + ((wgid % nig) % gsz); u.pn = (wgid % nig) / gsz; return true;
  }
};

template <class Epi>
__device__ __forceinline__ void gemm_phase(LAS unsigned char* lds, const Gemm g, const StaticOrder& S, const Epi& E) {
  const int tid = threadIdx.x, wid = __builtin_amdgcn_readfirstlane(tid >> 6), lane = tid & 63, wr = wid >> 2, wc = wid & 3, fr = lane & 15, fq = lane >> 4;
  int K = g.K; asm volatile("" : "+s"(K));
  const int nt = K / BK;
  unsigned voffA[2], voffB[2];
#pragma unroll
  for (int i = 0; i < 2; ++i) { int R, C; stage_rc(tid * 16 + i * 8192, R, C); const int Rb = Epi::PERM ? ((R & ~31) + perm32(R & 31)) : R;
    voffA[i] = (unsigned)(R * K + C) * 2u; voffB[i] = (unsigned)(Rb * K + C) * 2u; }
  const size_t kstep = (size_t)(BK * 2);
  const size_t hstep = (size_t)HALF * K * 2;
  const size_t tstep = 2 * hstep;
  const unsigned ldsw = (unsigned)wid * 1024u;
  const int aoff = lds_byte(wr * 64 + fr, fq * 8), boff = lds_byte(wc * 32 + fr, fq * 8);
#define PG8_SA(b, h) (((b) * 2 + (h)) * HTB)
#define PG8_SB(b, h) ((4 + (b) * 2 + (h)) * HTB)
#define PG8_STAGE(bufoff, gbase, voff) do { _Pragma("unroll") for (int _i = 0; _i < 2; ++_i) \
    __builtin_amdgcn_global_load_lds((const unsigned*)((const char*)(gbase) + (voff)[_i]), (LAS unsigned*)(lds + (bufoff) + ldsw + _i * 8192), 16, 0, 0); } while (0)
#define PG8_LDA(dst, b, h) do { _Pragma("unroll") for (int m = 0; m < 4; ++m) _Pragma("unroll") for (int k = 0; k < 2; ++k) dst[m][k] = *(const LAS bf16x8*)(lds + PG8_SA(b, h) + aoff + m * 2048 + k * 1024); } while (0)
#define PG8_LDB(dst, b, h) do { _Pragma("unroll") for (int n = 0; n < 2; ++n) _Pragma("unroll") for (int k = 0; k < 2; ++k) dst[n][k] = *(const LAS bf16x8*)(lds + PG8_SB(b, h) + boff + n * 2048 + k * 1024); } while (0)
#define PG8_MMA(ai, bj, At, Bt) do { __builtin_amdgcn_s_setprio(1); _Pragma("unroll") for (int m = 0; m < 4; ++m) _Pragma("unroll") for (int n = 0; n < 2; ++n) _Pragma("unroll") for (int k = 0; k < 2; ++k) \
    acc[ai][bj][m][n] = __builtin_amdgcn_mfma_f32_16x16x32_bf16(Bt[n][k], At[m][k], acc[ai][bj][m][n], 0, 0, 0); __builtin_amdgcn_s_setprio(0); } while (0)
#define PG8_WAIT_V(n) asm volatile("s_waitcnt vmcnt(" #n ")" ::: "memory")
#define PG8_WAIT_L(n) asm volatile("s_waitcnt lgkmcnt(" #n ")" ::: "memory")
#define PG8_BAR __builtin_amdgcn_s_barrier()
#define PG8_SCHED __builtin_amdgcn_sched_barrier(0)
  Unit cur, nxt; int ui = 0;
  if (!S.next(0, cur)) return;
  f32x4 acc[2][2][4][2];
#pragma unroll
  for (int a = 0; a < 2; ++a)
#pragma unroll
    for (int b = 0; b < 2; ++b)
#pragma unroll
      for (int m = 0; m < 4; ++m)
#pragma unroll
        for (int n = 0; n < 2; ++n) acc[a][b][m][n] = (f32x4){0.f, 0.f, 0.f, 0.f};
  bf16x8 At[4][2], B0[2][2], B1[2][2];
  const char* cA = (const char*)g.A + (size_t)cur.pm * tstep; const char* cB = (const char*)g.Bt + (size_t)cur.pn * tstep;
  PG8_STAGE(PG8_SB(0, 0), cB, voffB); PG8_STAGE(PG8_SA(0, 0), cA, voffA); PG8_STAGE(PG8_SB(0, 1), cB + hstep, voffB); PG8_STAGE(PG8_SA(0, 1), cA + hstep, voffA);
  if (wr == 1) PG8_BAR;
  PG8_WAIT_V(4); PG8_BAR;
  PG8_STAGE(PG8_SB(1, 0), cB + kstep, voffB); PG8_STAGE(PG8_SA(1, 0), cA + kstep, voffA); PG8_STAGE(PG8_SB(1, 1), cB + hstep + kstep, voffB);
  PG8_WAIT_V(6); PG8_BAR;
  for (;;) {
    const bool has_next = S.next(ui + 1, nxt);
    const char* nA = has_next ? (const char*)g.A + (size_t)nxt.pm * tstep : cA; const char* nB = has_next ? (const char*)g.Bt + (size_t)nxt.pn * tstep : cB;
    for (int t = 0; t < nt; t += 2) {
      const bool last = (t == nt - 2);
      const char* a1 = cA + (size_t)(t + 1) * kstep;
      const char* a2 = last ? nA : cA + (size_t)(t + 2) * kstep; const char* b2 = last ? nB : cB + (size_t)(t + 2) * kstep;
      const char* a3 = a2 + kstep; const char* b3 = b2 + kstep;
      PG8_LDB(B0, 0, 0); PG8_SCHED; PG8_LDA(At, 0, 0); PG8_STAGE(PG8_SA(1, 1), a1 + hstep, voffA);
      PG8_WAIT_L(8); PG8_BAR; PG8_WAIT_L(0); PG8_MMA(0, 0, At, B0); PG8_BAR; PG8_SCHED;
      PG8_LDB(B1, 0, 1); PG8_STAGE(PG8_SB(0, 0), b2, voffB);
      PG8_BAR; PG8_WAIT_L(0); PG8_MMA(0, 1, At, B1); PG8_BAR;
      PG8_LDA(At, 0, 1); PG8_STAGE(PG8_SA(0, 0), a2, voffA);
      PG8_BAR; PG8_WAIT_L(0); PG8_MMA(1, 0, At, B0); PG8_BAR; PG8_SCHED;
      PG8_STAGE(PG8_SB(0, 1), b2 + hstep, voffB);
      PG8_WAIT_V(6); PG8_BAR; PG8_MMA(1, 1, At, B1); PG8_BAR;
      PG8_LDB(B0, 1, 0); PG8_SCHED; PG8_LDA(At, 1, 0); PG8_STAGE(PG8_SA(0, 1), a2 + hstep, voffA);
      PG8_WAIT_L(8); PG8_BAR; PG8_WAIT_L(0); PG8_MMA(0, 0, At, B0); PG8_BAR; PG8_SCHED;
      PG8_LDB(B1, 1, 1); PG8_STAGE(PG8_SB(1, 0), b3, voffB);
      PG8_BAR; PG8_WAIT_L(0); PG8_MMA(0, 1, At, B1); PG8_BAR;
      PG8_LDA(At, 1, 1); PG8_STAGE(PG8_SA(1, 0), a3, voffA);
      PG8_BAR; PG8_WAIT_L(0); PG8_MMA(1, 0, At, B0); PG8_BAR; PG8_SCHED;
      PG8_STAGE(PG8_SB(1, 1), b3 + hstep, voffB);
      PG8_WAIT_V(6); PG8_BAR; PG8_MMA(1, 1, At, B1); PG8_BAR;
    }
    if constexpr (!Epi::AFTER_DRAIN) E(acc, cur, wr, wc, fr, fq);
    if (!has_next) break;
#pragma unroll
    for (int a = 0; a < 2; ++a)
#pragma unroll
      for (int b = 0; b < 2; ++b)
#pragma unroll
        for (int m = 0; m < 4; ++m)
#pragma unroll
          for (int n = 0; n < 2; ++n) acc[a][b][m][n] = (f32x4){0.f, 0.f, 0.f, 0.f};
    cur = nxt; cA = nA; cB = nB; ++ui;
  }
  PG8_WAIT_V(0);
  if (wr == 0) PG8_BAR;
  PG8_BAR;
  if constexpr (Epi::AFTER_DRAIN) E(acc, cur, wr, wc, fr, fq);
#undef PG8_SA
#undef PG8_SB
#undef PG8_STAGE
#undef PG8_LDA
#undef PG8_LDB
#undef PG8_MMA
#undef PG8_WAIT_V
#undef PG8_WAIT_L
#undef PG8_BAR
#undef PG8_SCHED
}
}

typedef f32x4 AccT[2][2][4][2];
#define EPI_FENCE() asm volatile("" ::: "memory")
__device__ __forceinline__ u32x4 pack8(f32x4 a, f32x4 b) { u32x4 w; w.x = cvt_pk_bf16(a[0], a[1]); w.y = cvt_pk_bf16(a[2], a[3]); w.z = cvt_pk_bf16(b[0], b[1]); w.w = cvt_pk_bf16(b[2], b[3]); return w; }
__device__ __forceinline__ float dot4(f32x4 a) { return (a[0] * a[0] + a[1] * a[1]) + (a[2] * a[2] + a[3] * a[3]); }

struct EpiProj {
  static constexpr bool PERM = true, AFTER_DRAIN = false;
  bf16_t *cq, *ckv, *kr, *dq, *dk, *dv; float *ss_cq, *ss_ckv; const float *g_q, *g_kv, *cos_d, *sin_d, *cos_r, *sin_r;
  __device__ __forceinline__ void operator()(const AccT& acc, const pg8::Unit& u, int wr, int wc, int fr, int fq) const {
    const int row0 = u.pm * 256 + wr * 64 + fr, cw = wc * 32 + 8 * fq, pn = u.pn;
    if (pn < 3) {
      bf16_t* dst = pn < 2 ? cq : ckv; const int ld = pn < 2 ? 512 : 256, colt = pn < 2 ? pn * 256 : 0; const float* g = pn < 2 ? g_q : g_kv; float* ss = pn < 2 ? ss_cq : ss_ckv;
      f32x4 gv[2][2];
#pragma unroll
      for (int bj = 0; bj < 2; ++bj)
#pragma unroll
        for (int n = 0; n < 2; ++n) gv[bj][n] = *(const f32x4*)(g + colt + bj * 128 + cw + 4 * n);
#pragma unroll
      for (int ai = 0; ai < 2; ++ai)
#pragma unroll
        for (int m = 0; m < 4; ++m) { const int row = row0 + ai * 128 + m * 16; float s = 0.f;
#pragma unroll
          for (int bj = 0; bj < 2; ++bj) { const f32x4 v0 = acc[ai][bj][m][0], v1 = acc[ai][bj][m][1]; s += dot4(v0) + dot4(v1);
            *(u32x4*)(dst + (size_t)row * ld + colt + bj * 128 + cw) = pack8(v0 * gv[bj][0], v1 * gv[bj][1]); }
          s += __shfl_xor(s, 16); s += __shfl_xor(s, 32);
          if (fq == 0) unsafeAtomicAdd(ss + row, s); }
    } else if (pn == 3) {
      if (wc == 0) {
#pragma unroll
        for (int ai = 0; ai < 2; ++ai)
#pragma unroll
          for (int m = 0; m < 4; ++m) { const int row = row0 + ai * 128 + m * 16;
            f32x4 lo[2], hi[2];
#pragma unroll
            for (int n = 0; n < 2; ++n) { const f32x4 c = *(const f32x4*)(cos_r + (size_t)row * 32 + 8 * fq + 4 * n), s = *(const f32x4*)(sin_r + (size_t)row * 32 + 8 * fq + 4 * n);
              const f32x4 a = acc[ai][0][m][n], b = acc[ai][1][m][n]; lo[n] = a * c - b * s; hi[n] = a * s + b * c; }
            *(u32x4*)(kr + (size_t)row * 64 + 8 * fq) = pack8(lo[0], lo[1]);
            *(u32x4*)(kr + (size_t)row * 64 + 32 + 8 * fq) = pack8(hi[0], hi[1]); if (m & 1) EPI_FENCE(); }
      }
    } else if (pn < 12) {
      bf16_t* dst = pn < 8 ? dq : dk; const int head = (pn - 4) & 3, sub = wc >> 1, i0 = 32 * (wc & 1) + 8 * fq;
#pragma unroll
      for (int ai = 0; ai < 2; ++ai)
#pragma unroll
        for (int m = 0; m < 4; ++m) { const int row = row0 + ai * 128 + m * 16;
          f32x4 lo[2], hi[2];
#pragma unroll
          for (int n = 0; n < 2; ++n) { const f32x4 c = *(const f32x4*)(cos_d + (size_t)row * 64 + i0 + 4 * n), s = *(const f32x4*)(sin_d + (size_t)row * 64 + i0 + 4 * n);
            const f32x4 a = acc[ai][0][m][n], b = acc[ai][1][m][n]; lo[n] = a * c - b * s; hi[n] = a * s + b * c; }
          bf16_t* p = dst + (size_t)row * 1024 + head * 256 + sub * 128 + i0;
          *(u32x4*)p = pack8(lo[0], lo[1]); *(u32x4*)(p + 64) = pack8(hi[0], hi[1]); if (m & 1) EPI_FENCE(); }
    } else {
      const int head = pn - 12;
#pragma unroll
      for (int ai = 0; ai < 2; ++ai)
#pragma unroll
        for (int m = 0; m < 4; ++m) { const int row = row0 + ai * 128 + m * 16;
#pragma unroll
          for (int bj = 0; bj < 2; ++bj) *(u32x4*)(dv + (size_t)row * 1024 + head * 256 + bj * 128 + cw) = pack8(acc[ai][bj][m][0], acc[ai][bj][m][1]); }
    }
  }
};
struct EpiQ {
  static constexpr bool PERM = true, AFTER_DRAIN = false;
  bf16_t *qn, *qr; const float *ss, *cos_r, *sin_r;
  __device__ __forceinline__ void operator()(const AccT& acc, const pg8::Unit& u, int wr, int wc, int fr, int fq) const {
    const int row0 = u.pm * 256 + wr * 64 + fr, cw = wc * 32 + 8 * fq, pn = u.pn;
    float rr[2][4];
#pragma unroll
    for (int ai = 0; ai < 2; ++ai)
#pragma unroll
      for (int m = 0; m < 4; ++m) rr[ai][m] = ss[row0 + ai * 128 + m * 16];
    if (pn < 4) {
#pragma unroll
      for (int ai = 0; ai < 2; ++ai)
#pragma unroll
        for (int m = 0; m < 4; ++m) { const int row = row0 + ai * 128 + m * 16; const float r = rsqrtf(rr[ai][m] * (1.f / 512.f) + NORM_EPS);
#pragma unroll
          for (int bj = 0; bj < 2; ++bj) *(u32x4*)(qn + (size_t)row * 1024 + pn * 256 + bj * 128 + cw) = pack8(acc[ai][bj][m][0] * r, acc[ai][bj][m][1] * r);
          EPI_FENCE(); }
    } else {
      const int head = 4 * (pn - 4) + wc;
#pragma unroll
      for (int ai = 0; ai < 2; ++ai)
#pragma unroll
        for (int m = 0; m < 4; ++m) { const int row = row0 + ai * 128 + m * 16; const float r = rsqrtf(rr[ai][m] * (1.f / 512.f) + NORM_EPS);
          bf16_t* p = qr + (size_t)row * 512 + head * 64 + 8 * fq;
          f32x4 lo[2], hi2[2];
#pragma unroll
          for (int n = 0; n < 2; ++n) { const f32x4 c = *(const f32x4*)(cos_r + (size_t)row * 32 + 8 * fq + 4 * n), s = *(const f32x4*)(sin_r + (size_t)row * 32 + 8 * fq + 4 * n);
            const f32x4 a = acc[ai][0][m][n] * r, b = acc[ai][1][m][n] * r; lo[n] = a * c - b * s; hi2[n] = a * s + b * c; }
          *(u32x4*)p = pack8(lo[0], lo[1]); *(u32x4*)(p + 32) = pack8(hi2[0], hi2[1]);
          EPI_FENCE(); }
    }
  }
};
struct EpiKV {
  static constexpr bool PERM = true, AFTER_DRAIN = false;
  bf16_t *kn, *vm; const float* ss;
  __device__ __forceinline__ void operator()(const AccT& acc, const pg8::Unit& u, int wr, int wc, int fr, int fq) const {
    const int row0 = u.pm * 256 + wr * 64 + fr, cw = wc * 32 + 8 * fq, pn = u.pn;
    float rr[2][4];
#pragma unroll
    for (int ai = 0; ai < 2; ++ai)
#pragma unroll
      for (int m = 0; m < 4; ++m) rr[ai][m] = ss[row0 + ai * 128 + m * 16];
#pragma unroll
    for (int ai = 0; ai < 2; ++ai)
#pragma unroll
      for (int m = 0; m < 4; ++m) { const int row = row0 + ai * 128 + m * 16; const float r = rsqrtf(rr[ai][m] * (1.f / 256.f) + NORM_EPS);
        *(u32x4*)(kn + (size_t)row * 1024 + pn * 128 + cw) = pack8(acc[ai][0][m][0] * r, acc[ai][0][m][1] * r);
        *(u32x4*)(vm + (size_t)row * 1024 + pn * 128 + cw) = pack8(acc[ai][1][m][0] * r, acc[ai][1][m][1] * r); EPI_FENCE(); }
  }
};
struct EpiScale {
  static constexpr bool PERM = true, AFTER_DRAIN = false;
  bf16_t* out; int ld; const float* ss; float inv_n;
  __device__ __forceinline__ void operator()(const AccT& acc, const pg8::Unit& u, int wr, int wc, int fr, int fq) const {
    const int row0 = u.pm * 256 + wr * 64 + fr, cw = wc * 32 + 8 * fq, pn = u.pn;
    float rr[2][4];
#pragma unroll
    for (int ai = 0; ai < 2; ++ai)
#pragma unroll
      for (int m = 0; m < 4; ++m) rr[ai][m] = ss ? ss[row0 + ai * 128 + m * 16] : 0.f;
#pragma unroll
    for (int ai = 0; ai < 2; ++ai)
#pragma unroll
      for (int m = 0; m < 4; ++m) { const int row = row0 + ai * 128 + m * 16; const float r = ss ? rsqrtf(rr[ai][m] * inv_n + NORM_EPS) : 1.f;
#pragma unroll
        for (int bj = 0; bj < 2; ++bj) *(u32x4*)(out + (size_t)row * ld + pn * 256 + bj * 128 + cw) = pack8(acc[ai][bj][m][0] * r, acc[ai][bj][m][1] * r);
        EPI_FENCE(); }
  }
};
struct EpiRes {
  static constexpr bool PERM = true, AFTER_DRAIN = false;
  const float* base; float* X; bf16_t* xb; const float* g; float* ss;
  __device__ __forceinline__ void operator()(const AccT& acc, const pg8::Unit& u, int wr, int wc, int fr, int fq) const {
    const int row0 = u.pm * 256 + wr * 64 + fr, col0 = u.pn * 256 + wc * 32 + 8 * fq;
#pragma unroll
    for (int ai = 0; ai < 2; ++ai)
#pragma unroll
      for (int m = 0; m < 4; ++m) { const int row = row0 + ai * 128 + m * 16; const size_t off = (size_t)row * DM + col0; float s = 0.f;
#pragma unroll
        for (int bj = 0; bj < 2; ++bj) { const int co = bj * 128;
          const f32x4 v0 = *(const f32x4*)(base + off + co) + acc[ai][bj][m][0], v1 = *(const f32x4*)(base + off + co + 4) + acc[ai][bj][m][1];
          *(f32x4*)(X + off + co) = v0; *(f32x4*)(X + off + co + 4) = v1; s += dot4(v0) + dot4(v1);
          if (xb) { const f32x4 g0 = *(const f32x4*)(g + col0 + co), g1 = *(const f32x4*)(g + col0 + co + 4); *(u32x4*)(xb + off + co) = pack8(v0 * g0, v1 * g1); } }
        s += __shfl_xor(s, 16); s += __shfl_xor(s, 32);
        if (fq == 0) unsafeAtomicAdd(ss + row, s);
        if (m & 1) EPI_FENCE(); }
  }
};
struct EpiFinal {
  static constexpr bool PERM = true, AFTER_DRAIN = true;
  float* X; const float* g; float* ss; unsigned* cnt;
  __device__ __forceinline__ void operator()(AccT& acc, const pg8::Unit& u, int wr, int wc, int fr, int fq) const {
    const int row0 = u.pm * 256 + wr * 64 + fr, col0 = u.pn * 256 + wc * 32 + 8 * fq;
#pragma unroll
    for (int ai = 0; ai < 2; ++ai)
#pragma unroll
      for (int m = 0; m < 4; ++m) { const int row = row0 + ai * 128 + m * 16; const size_t off = (size_t)row * DM + col0; float s = 0.f;
#pragma unroll
        for (int bj = 0; bj < 2; ++bj)
#pragma unroll
          for (int n = 0; n < 2; ++n) { const int co = bj * 128 + n * 4; const f32x4 v = *(const f32x4*)(X + off + co) + acc[ai][bj][m][n]; acc[ai][bj][m][n] = v; s += dot4(v); }
        s += __shfl_xor(s, 16); s += __shfl_xor(s, 32);
        if (fq == 0) unsafeAtomicAdd(ss + row, s);
        if (m & 1) EPI_FENCE(); }
    asm volatile("s_waitcnt vmcnt(0)" ::: "memory");
    unsigned* cw = cnt + 64 * u.pm;
    if (fr == 0 && fq == 0) __hip_atomic_fetch_add(cw, 1u, __ATOMIC_RELAXED, __HIP_MEMORY_SCOPE_AGENT);
    { unsigned polls = 0;
      while ((unsigned)__builtin_amdgcn_readfirstlane(__hip_atomic_load(cw, __ATOMIC_RELAXED, __HIP_MEMORY_SCOPE_AGENT)) < 64u) { __builtin_amdgcn_s_sleep(2); if (++polls > (1u << 22)) break; } }
    EPI_FENCE();
#pragma unroll
    for (int ai = 0; ai < 2; ++ai)
#pragma unroll
      for (int m = 0; m < 4; ++m) { const int row = row0 + ai * 128 + m * 16; const size_t off = (size_t)row * DM + col0;
        const float r = rsqrtf(__hip_atomic_load(ss + row, __ATOMIC_RELAXED, __HIP_MEMORY_SCOPE_AGENT) * (1.f / DM) + NORM_EPS);
#pragma unroll
        for (int bj = 0; bj < 2; ++bj)
#pragma unroll
          for (int n = 0; n < 2; ++n) { const int co = bj * 128 + n * 4; const f32x4 gv = *(const f32x4*)(g + col0 + co); *(f32x4*)(X + off + co) = acc[ai][bj][m][n] * gv * r; }
        EPI_FENCE(); }
  }
};
struct EpiSwiGLU {
  static constexpr bool PERM = true, AFTER_DRAIN = false;
  bf16_t* hid; const float* ss;
  __device__ __forceinline__ void operator()(const AccT& acc, const pg8::Unit& u, int wr, int wc, int fr, int fq) const {
    typedef float f32x2 __attribute__((ext_vector_type(2)));
    const int row0 = u.pm * 256 + wr * 64 + fr, cw = wc * 32 + 8 * fq, pn = u.pn;
    float rr[2][4];
#pragma unroll
    for (int ai = 0; ai < 2; ++ai)
#pragma unroll
      for (int m = 0; m < 4; ++m) rr[ai][m] = ss[row0 + ai * 128 + m * 16];
#pragma unroll
    for (int ai = 0; ai < 2; ++ai)
#pragma unroll
      for (int m = 0; m < 4; ++m) { const int row = row0 + ai * 128 + m * 16; const float r = rsqrtf(rr[ai][m] * (1.f / 2048.f) + NORM_EPS);
        const float cr = -1.4426950408889634f * r, r2 = r * r;
        u32x4 w;
#pragma unroll
        for (int n = 0; n < 2; ++n)
#pragma unroll
          for (int hf = 0; hf < 2; ++hf) { const f32x2 g = {acc[ai][0][m][n][2 * hf], acc[ai][0][m][n][2 * hf + 1]}, up = {acc[ai][1][m][n][2 * hf], acc[ai][1][m][n][2 * hf + 1]};
            const f32x2 t = g * cr; f32x2 e; e.x = __builtin_amdgcn_exp2f(t.x); e.y = __builtin_amdgcn_exp2f(t.y);
            const f32x2 d = e + 1.0f; f32x2 q; q.x = __builtin_amdgcn_rcpf(d.x); q.y = __builtin_amdgcn_rcpf(d.y);
            const f32x2 h = (g * up) * (q * r2);
            w[n * 2 + hf] = cvt_pk_bf16(h.x, h.y); }
        *(u32x4*)(hid + (size_t)row * FFN + pn * 128 + cw) = w; EPI_FENCE(); }
  }
};

namespace at {
constexpr int KVBLK = 64;
constexpr int SHM_V = KVBLK * 128 * 2, SHM_K = KVBLK * 128 * 2, SHM_KR = KVBLK * 64 * 2;
constexpr int OFF_V = 0, OFF_K = 2 * SHM_V, OFF_KR = OFF_K + 2 * SHM_K, OFF_WS = OFF_KR + 2 * SHM_KR, OFF_QR = OFF_WS + 8 * 64 * 4, LDS_ATTN = OFF_QR + 8 * 8192;
constexpr int LDKV = 1024;
#define KSWZ(row, colB) ((row) * 256 + ((colB) ^ (((row) & 7) << 4)))
#define KRSWZ(row, chunk) ((row) * 128 + ((((chunk) ^ (((row) >> 1) & 7))) << 4))
#define SBAR() __builtin_amdgcn_sched_barrier(0)
__device__ __forceinline__ int crow(int r, int hi) { return (r & 3) + 8 * (r >> 2) + 4 * hi; }

__device__ __forceinline__ void partialSM(f32x16& p0, f32x16& p1, float& m_reg, float& mn, float& alpha, const float C, const float thr_raw) {
  float pmax = p0[0];
#pragma unroll
  for (int r = 1; r < 16; ++r) pmax = fmaxf(pmax, p0[r]);
#pragma unroll
  for (int r = 0; r < 16; ++r) pmax = fmaxf(pmax, p1[r]);
  { auto rr = __builtin_amdgcn_permlane32_swap(__float_as_uint(pmax), __float_as_uint(pmax), false, false);
    pmax = fmaxf(__uint_as_float(rr[0]), __uint_as_float(rr[1])); }
  if (__builtin_expect(__all(pmax - m_reg <= thr_raw), 1)) { mn = m_reg; alpha = 1.f; }
  else { mn = fmaxf(m_reg, pmax); alpha = __builtin_amdgcn_exp2f((m_reg - mn) * C); m_reg = mn; }
  const float mnC = -mn * C;
#pragma unroll
  for (int r = 0; r < 16; ++r) p0[r] = fmaf(p0[r], C, mnC);
#pragma unroll
  for (int r = 0; r < 16; ++r) p1[r] = fmaf(p1[r], C, mnC);
#pragma unroll
  for (int r = 0; r < 16; ++r) p0[r] = __builtin_amdgcn_exp2f(p0[r]);
}
__device__ __forceinline__ void finishSM(f32x16& p0, f32x16& p1, float alpha, float& l_reg, bf16x8& pa0, bf16x8& pa1, bf16x8& pa2, bf16x8& pa3) {
#pragma unroll
  for (int r = 0; r < 16; ++r) p1[r] = __builtin_amdgcn_exp2f(p1[r]);
  float ps = 0;
#pragma unroll
  for (int r = 0; r < 16; ++r) ps += p0[r];
#pragma unroll
  for (int r = 0; r < 16; ++r) ps += p1[r];
  { auto rr = __builtin_amdgcn_permlane32_swap(__float_as_uint(ps), __float_as_uint(ps), false, false);
    ps = __uint_as_float(rr[0]) + __uint_as_float(rr[1]); }
  l_reg = l_reg * alpha + ps;
#define PK4(P, BASE, OUT) do { unsigned a0 = cvt_pk_bf16(P[BASE + 0], P[BASE + 1]), a1 = cvt_pk_bf16(P[BASE + 2], P[BASE + 3]);   \
    unsigned b0 = cvt_pk_bf16(P[BASE + 4], P[BASE + 5]), b1 = cvt_pk_bf16(P[BASE + 6], P[BASE + 7]);                              \
    auto r0 = __builtin_amdgcn_permlane32_swap(a0, b0, false, false); auto r1 = __builtin_amdgcn_permlane32_swap(a1, b1, false, false); \
    u32x4 w = {r0[0], r1[0], r0[1], r1[1]}; OUT = *reinterpret_cast<bf16x8*>(&w); } while (0)
  PK4(p0, 0, pa0); PK4(p0, 8, pa1); PK4(p1, 0, pa2); PK4(p1, 8, pa3);
#undef PK4
}
template <int NQK, int NREG>
__device__ __forceinline__ void qkt(f32x16& p0, f32x16& p1, const char* Ks, const char* KRs, const bf16x8* qr, const char* qrl, int r32, int hi) {
  p0 = f32x16{}; p1 = f32x16{};
#pragma unroll
  for (int d0 = 0; d0 < 8; ++d0) { const int cb = (d0 * 16 + hi * 8) * 2;
    bf16x8 b0 = *reinterpret_cast<const bf16x8*>(Ks + KSWZ(r32, cb));
    bf16x8 b1 = *reinterpret_cast<const bf16x8*>(Ks + KSWZ(32 + r32, cb));
    bf16x8 qq; if (d0 < NREG) qq = qr[d0 < NREG ? d0 : 0]; else qq = *reinterpret_cast<const bf16x8*>(qrl + KRSWZ(r32, (d0 - 4) * 2 + hi));
    p0 = __builtin_amdgcn_mfma_f32_32x32x16_bf16(b0, qq, p0, 0, 0, 0);
    p1 = __builtin_amdgcn_mfma_f32_32x32x16_bf16(b1, qq, p1, 0, 0, 0); }
  if constexpr (NQK == 12) {
#pragma unroll
    for (int d0 = 0; d0 < 4; ++d0) { const int ch = d0 * 2 + hi;
      bf16x8 b0 = *reinterpret_cast<const bf16x8*>(KRs + KRSWZ(r32, ch));
      bf16x8 b1 = *reinterpret_cast<const bf16x8*>(KRs + KRSWZ(32 + r32, ch));
      const bf16x8 qq = *reinterpret_cast<const bf16x8*>(qrl + 4096 + KRSWZ(r32, ch));
      p0 = __builtin_amdgcn_mfma_f32_32x32x16_bf16(b0, qq, p0, 0, 0, 0);
      p1 = __builtin_amdgcn_mfma_f32_32x32x16_bf16(b1, qq, p1, 0, 0, 0); }
  }
}
__device__ __forceinline__ int v_st(int k, int c) { const int kk = (k & ~0xC) | ((k & 4) << 1) | ((k & 8) >> 1); return ((kk >> 3) * 4 + (c >> 5)) * 512 + ((kk & 7) * 32 + (c & 31)) * 2; }
__device__ __forceinline__ int v_rd_base(int lane) { return ((lane & 3) << 3) | (((lane >> 2) & 3) << 6) | (((lane >> 4) & 1) << 5) | (((lane >> 5) & 1) << 8); }
constexpr int v_rd_off(int d0, int ks, int half) { return d0 * 512 + ks * 4096 + half * 2048; }
template <int OFF> __device__ __forceinline__ s16x4 tr_read(int vb) {
  s16x4 r; asm volatile("ds_read_b64_tr_b16 %0, %1 offset:%2" : "=&v"(r) : "v"(vb), "i"(OFF) : "memory"); return r;
}
template <int D0> __device__ __forceinline__ void pv_one(f32x16& od, int vb, bf16x8 pa0, bf16x8 pa1, bf16x8 pa2, bf16x8 pa3) {
  const s16x4 l0 = tr_read<v_rd_off(D0, 0, 0)>(vb), h0 = tr_read<v_rd_off(D0, 0, 1)>(vb), l1 = tr_read<v_rd_off(D0, 1, 0)>(vb), h1 = tr_read<v_rd_off(D0, 1, 1)>(vb);
  const s16x4 l2 = tr_read<v_rd_off(D0, 2, 0)>(vb), h2 = tr_read<v_rd_off(D0, 2, 1)>(vb), l3 = tr_read<v_rd_off(D0, 3, 0)>(vb), h3 = tr_read<v_rd_off(D0, 3, 1)>(vb);
  asm volatile("s_waitcnt lgkmcnt(0)" ::: "memory"); SBAR();
#define PK(L, H) (bf16x8){L[0], L[1], L[2], L[3], H[0], H[1], H[2], H[3]}
  od = __builtin_amdgcn_mfma_f32_32x32x16_bf16(pa0, PK(l0, h0), od, 0, 0, 0);
  od = __builtin_amdgcn_mfma_f32_32x32x16_bf16(pa1, PK(l1, h1), od, 0, 0, 0);
  od = __builtin_amdgcn_mfma_f32_32x32x16_bf16(pa2, PK(l2, h2), od, 0, 0, 0);
  od = __builtin_amdgcn_mfma_f32_32x32x16_bf16(pa3, PK(l3, h3), od, 0, 0, 0);
#undef PK
}
__device__ __forceinline__ void pv_d0(f32x16* o, int vb, bf16x8 pa0, bf16x8 pa1, bf16x8 pa2, bf16x8 pa3) {
  pv_one<0>(o[0], vb, pa0, pa1, pa2, pa3); pv_one<1>(o[1], vb, pa0, pa1, pa2, pa3); pv_one<2>(o[2], vb, pa0, pa1, pa2, pa3); pv_one<3>(o[3], vb, pa0, pa1, pa2, pa3);
}

template <int NQK, int LDQ, int LDQR, int SD, int NREG>
__device__ __forceinline__ void attn_core(f32x16 (&o)[4], const bf16_t* __restrict__ Qb, const bf16_t* __restrict__ Qrb, const bf16_t* __restrict__ Kh, const bf16_t* __restrict__ Krh,
                                          const bf16_t* __restrict__ Vh, const int seq, const float C, const float thr_raw, char* lds) {
  const int tid = threadIdx.x, wid = tid >> 6, lane = tid & 63, r32 = lane & 31, hi = lane >> 5;
  char* V_lds = lds + OFF_V; char* K_lds = lds + OFF_K; char* KR_lds = lds + OFF_KR;
  float* ws = (float*)(lds + OFF_WS) + wid * 64; float* li_l = ws; float* al_l = ws + 32;
  float m_reg = -1e30f, l_reg = 0;
#pragma unroll
  for (int d = 0; d < 4; ++d) o[d] = f32x16{};
  bf16x8 qr[NREG]; char* qrl = lds + OFF_QR + wid * 8192;
  { const bf16_t* Qw = Qb + (long)(wid * 32 + r32) * LDQ + hi * 8;
#pragma unroll
    for (int d0 = 0; d0 < NREG; ++d0) { qr[d0] = *reinterpret_cast<const bf16x8*>(Qw + d0 * 16); asm volatile("" : "+v"(qr[d0])); }
    if constexpr (NREG == 4) {
#pragma unroll
      for (int d0 = 0; d0 < 4; ++d0) *reinterpret_cast<bf16x8*>(qrl + KRSWZ(r32, d0 * 2 + hi)) = *reinterpret_cast<const bf16x8*>(Qw + (4 + d0) * 16); }
    if constexpr (NQK == 12) { const bf16_t* Qw2 = Qrb + (long)(wid * 32 + r32) * LDQR + hi * 8;
#pragma unroll
      for (int d0 = 0; d0 < 4; ++d0) *reinterpret_cast<bf16x8*>(qrl + 4096 + KRSWZ(r32, d0 * 2 + hi)) = *reinterpret_cast<const bf16x8*>(Qw2 + d0 * 16); } }
  const int sr = tid >> 4, sc = (tid & 15) * 8, vst0 = v_st(sr, sc), vst1 = v_st(32 + sr, sc);
  const unsigned soff = (unsigned)(sr * LDKV + sc);
  const int krr = tid >> 3, krc = tid & 7;
  const int vb0 = (int)(uintptr_t)(LAS char*)V_lds + v_rd_base(lane);
  struct { bf16x8 vs0, vs1, ks0, ks1, kr; } sr_[SD];
#define SLOAD(i, k0) do { const bf16_t* vb_ = Vh + (size_t)(k0) * LDKV; const bf16_t* kb_ = Kh + (size_t)(k0) * LDKV;     \
    sr_[i].vs0 = *reinterpret_cast<const bf16x8*>(vb_ + soff); sr_[i].vs1 = *reinterpret_cast<const bf16x8*>(vb_ + 32 * LDKV + soff); \
    sr_[i].ks0 = *reinterpret_cast<const bf16x8*>(kb_ + soff); sr_[i].ks1 = *reinterpret_cast<const bf16x8*>(kb_ + 32 * LDKV + soff); \
    if constexpr (NQK == 12) sr_[i].kr = *reinterpret_cast<const bf16x8*>(&Krh[(long)((k0) + krr) * 64 + krc * 8]); } while (0)
#define SWRITE(b, i) do { *(bf16x8*)(V_lds + (b) * SHM_V + vst0) = sr_[i].vs0;          \
    *(bf16x8*)(V_lds + (b) * SHM_V + vst1) = sr_[i].vs1; const int kc = sc * 2;               \
    *(bf16x8*)(K_lds + (b) * SHM_K + KSWZ(sr, kc)) = sr_[i].ks0;                       \
    *(bf16x8*)(K_lds + (b) * SHM_K + KSWZ(32 + sr, kc)) = sr_[i].ks1; \
    if constexpr (NQK == 12) *(bf16x8*)(KR_lds + (b) * SHM_KR + KRSWZ(krr, krc)) = sr_[i].kr; } while (0)
#define SWAIT() do { if constexpr (SD == 1) asm volatile("s_waitcnt vmcnt(0)" ::: "memory"); else if constexpr (NQK == 12) asm volatile("s_waitcnt vmcnt(5)" ::: "memory"); else asm volatile("s_waitcnt vmcnt(4)" ::: "memory"); } while (0)
#define RESC(a) do { if (__any((a) < 1.f)) { if (hi == 0) al_l[r32] = (a); asm volatile("s_waitcnt lgkmcnt(0)" ::: "memory"); \
    _Pragma("unroll") for (int d = 0; d < 4; ++d) _Pragma("unroll") for (int r = 0; r < 16; ++r) o[d][r] *= al_l[crow(r, hi)]; } } while (0)
  f32x16 pA0, pA1, pB0, pB1; float mnA, mnB, alA, alB; bf16x8 pa0, pa1, pa2, pa3; const int NT = seq / KVBLK;
  constexpr int SE = 0, SO = SD - 1;
  SLOAD(SE, 0); asm volatile("s_waitcnt vmcnt(0)" ::: "memory"); SWRITE(0, SE); __syncthreads();
  qkt<NQK, NREG>(pA0, pA1, K_lds, KR_lds, qr, qrl, r32, hi); partialSM(pA0, pA1, m_reg, mnA, alA, C, thr_raw);
  SLOAD(SO, KVBLK); if constexpr (SD == 2) { if (2 < NT) SLOAD(SE, 2 * KVBLK); }
  SWAIT(); SWRITE(1, SO); __syncthreads();
  for (int j = 1; j + 1 < NT; j += 2) {
    SBAR(); qkt<NQK, NREG>(pB0, pB1, K_lds + SHM_K, KR_lds + SHM_KR, qr, qrl, r32, hi);
    finishSM(pA0, pA1, alA, l_reg, pa0, pa1, pa2, pa3); SBAR();
    SLOAD(SO, (j + SD) * KVBLK); SBAR();
    pv_d0(o, vb0, pa0, pa1, pa2, pa3); partialSM(pB0, pB1, m_reg, mnB, alB, C, thr_raw);
    __syncthreads(); SWAIT(); SWRITE(0, SE);
    RESC(alB); __syncthreads();
    SBAR(); qkt<NQK, NREG>(pA0, pA1, K_lds, KR_lds, qr, qrl, r32, hi);
    finishSM(pB0, pB1, alB, l_reg, pa0, pa1, pa2, pa3); SBAR();
    if (SD == 1 || j + 3 < NT) SLOAD(SE, (j + 1 + SD) * KVBLK); SBAR();
    pv_d0(o, vb0 + SHM_V, pa0, pa1, pa2, pa3); partialSM(pA0, pA1, m_reg, mnA, alA, C, thr_raw);
    __syncthreads(); SWAIT(); SWRITE(1, SO);
    RESC(alA); __syncthreads();
  }
  SBAR(); qkt<NQK, NREG>(pB0, pB1, K_lds + SHM_K, KR_lds + SHM_KR, qr, qrl, r32, hi);
  finishSM(pA0, pA1, alA, l_reg, pa0, pa1, pa2, pa3); SBAR();
  pv_d0(o, vb0, pa0, pa1, pa2, pa3); partialSM(pB0, pB1, m_reg, mnB, alB, C, thr_raw);
  __syncthreads(); RESC(alB);
  finishSM(pB0, pB1, alB, l_reg, pa0, pa1, pa2, pa3); SBAR();
  pv_d0(o, vb0 + SHM_V, pa0, pa1, pa2, pa3);
  if (hi == 0) li_l[r32] = l_reg; asm volatile("s_waitcnt lgkmcnt(0)" ::: "memory");
#pragma unroll
  for (int r = 0; r < 16; ++r) { const float rl = __builtin_amdgcn_rcpf(li_l[crow(r, hi)]);
#pragma unroll
    for (int d = 0; d < 4; ++d) o[d][r] *= rl; }
  __syncthreads();
#undef SLOAD
#undef SWRITE
#undef SWAIT
#undef RESC
}
template <int NQK, int LDQ, int LDQR, int NREG>
__device__ __forceinline__ void attn_core_simple(f32x16 (&o)[4], const bf16_t* __restrict__ Qb, const bf16_t* __restrict__ Qrb, const bf16_t* __restrict__ Kh, const bf16_t* __restrict__ Krh,
                                                 const bf16_t* __restrict__ Vh, const int seq, const float C, const float thr_raw, char* lds) {
  const int tid = threadIdx.x, wid = tid >> 6, lane = tid & 63, r32 = lane & 31, hi = lane >> 5;
  char* V_lds = lds + OFF_V; char* K_lds = lds + OFF_K; char* KR_lds = lds + OFF_KR;
  float* ws = (float*)(lds + OFF_WS) + wid * 64; float* li_l = ws; float* al_l = ws + 32;
  float m_reg = -1e30f, l_reg = 0;
#pragma unroll
  for (int d = 0; d < 4; ++d) o[d] = f32x16{};
  bf16x8 qr[NREG]; char* qrl = lds + OFF_QR + wid * 8192;
  { const bf16_t* Qw = Qb + (long)(wid * 32 + r32) * LDQ + hi * 8;
#pragma unroll
    for (int d0 = 0; d0 < NREG; ++d0) { qr[d0] = *reinterpret_cast<const bf16x8*>(Qw + d0 * 16); asm volatile("" : "+v"(qr[d0])); }
    if constexpr (NREG == 4) {
#pragma unroll
      for (int d0 = 0; d0 < 4; ++d0) *reinterpret_cast<bf16x8*>(qrl + KRSWZ(r32, d0 * 2 + hi)) = *reinterpret_cast<const bf16x8*>(Qw + (4 + d0) * 16); }
    if constexpr (NQK == 12) { const bf16_t* Qw2 = Qrb + (long)(wid * 32 + r32) * LDQR + hi * 8;
#pragma unroll
      for (int d0 = 0; d0 < 4; ++d0) *reinterpret_cast<bf16x8*>(qrl + 4096 + KRSWZ(r32, d0 * 2 + hi)) = *reinterpret_cast<const bf16x8*>(Qw2 + d0 * 16); } }
  const int sr = tid >> 4, sc = (tid & 15) * 8, vst0 = v_st(sr, sc), vst1 = v_st(32 + sr, sc);
  const int krr = tid >> 3, krc = tid & 7;
  const int vb0 = (int)(uintptr_t)(LAS char*)V_lds + v_rd_base(lane);
  bf16x8 vs0, vs1, ks0, ks1, kr;
#define SLOAD1(k0) do { vs0 = *reinterpret_cast<const bf16x8*>(&Vh[(long)((k0) + sr) * LDKV + sc]); vs1 = *reinterpret_cast<const bf16x8*>(&Vh[(long)((k0) + 32 + sr) * LDKV + sc]); \
    ks0 = *reinterpret_cast<const bf16x8*>(&Kh[(long)((k0) + sr) * LDKV + sc]); ks1 = *reinterpret_cast<const bf16x8*>(&Kh[(long)((k0) + 32 + sr) * LDKV + sc]); \
    if constexpr (NQK == 12) kr = *reinterpret_cast<const bf16x8*>(&Krh[(long)((k0) + krr) * 64 + krc * 8]); } while (0)
#define SWRITE1(b) do { *(bf16x8*)(V_lds + (b) * SHM_V + vst0) = vs0; *(bf16x8*)(V_lds + (b) * SHM_V + vst1) = vs1; const int kc = sc * 2; \
    *(bf16x8*)(K_lds + (b) * SHM_K + KSWZ(sr, kc)) = ks0; *(bf16x8*)(K_lds + (b) * SHM_K + KSWZ(32 + sr, kc)) = ks1; \
    if constexpr (NQK == 12) *(bf16x8*)(KR_lds + (b) * SHM_KR + KRSWZ(krr, krc)) = kr; } while (0)
  f32x16 p0, p1; float mn, al; bf16x8 pa0, pa1, pa2, pa3; const int NT = seq / KVBLK;
  SLOAD1(0); SWRITE1(0); __syncthreads();
  if (1 < NT) SLOAD1(KVBLK);
  for (int j = 0; j < NT; ++j) {
    const int b = j & 1;
    SBAR(); qkt<NQK, NREG>(p0, p1, K_lds + b * SHM_K, KR_lds + b * SHM_KR, qr, qrl, r32, hi);
    partialSM(p0, p1, m_reg, mn, al, C, thr_raw);
    if (__any(al < 1.f)) { if (hi == 0) al_l[r32] = al; asm volatile("s_waitcnt lgkmcnt(0)" ::: "memory");
#pragma unroll
      for (int d = 0; d < 4; ++d)
#pragma unroll
        for (int r = 0; r < 16; ++r) o[d][r] *= al_l[crow(r, hi)]; }
    finishSM(p0, p1, al, l_reg, pa0, pa1, pa2, pa3); SBAR();
    pv_d0(o, vb0 + b * SHM_V, pa0, pa1, pa2, pa3);
    if (j + 1 < NT) { SWRITE1(b ^ 1); if (j + 2 < NT) SLOAD1((j + 2) * KVBLK); }
    __syncthreads();
  }
  if (hi == 0) li_l[r32] = l_reg; asm volatile("s_waitcnt lgkmcnt(0)" ::: "memory");
#pragma unroll
  for (int r = 0; r < 16; ++r) { const float rl = __builtin_amdgcn_rcpf(li_l[crow(r, hi)]);
#pragma unroll
    for (int d = 0; d < 4; ++d) o[d][r] *= rl; }
#undef SLOAD1
#undef SWRITE1
}
template <int NQK, int LDQ, int LDQR, int NREG>
__device__ __forceinline__ void attn_core_stag(f32x16 (&o)[4], const bf16_t* __restrict__ Qb, const bf16_t* __restrict__ Qrb, const bf16_t* __restrict__ Kh, const bf16_t* __restrict__ Krh,
                                                 const bf16_t* __restrict__ Vh, const int seq, const float C, const float thr_raw, char* lds) {
  const int tid = threadIdx.x, wid = tid >> 6, lane = tid & 63, r32 = lane & 31, hi = lane >> 5;
  char* V_lds = lds + OFF_V; char* K_lds = lds + OFF_K; char* KR_lds = lds + OFF_KR;
  float* ws = (float*)(lds + OFF_WS) + wid * 64; float* li_l = ws; float* al_l = ws + 32;
  float m_reg = -1e30f, l_reg = 0;
#pragma unroll
  for (int d = 0; d < 4; ++d) o[d] = f32x16{};
  bf16x8 qr[NREG]; char* qrl = lds + OFF_QR + wid * 8192;
  { const bf16_t* Qw = Qb + (long)(wid * 32 + r32) * LDQ + hi * 8;
#pragma unroll
    for (int d0 = 0; d0 < NREG; ++d0) { qr[d0] = *reinterpret_cast<const bf16x8*>(Qw + d0 * 16); asm volatile("" : "+v"(qr[d0])); }
    if constexpr (NREG == 4) {
#pragma unroll
      for (int d0 = 0; d0 < 4; ++d0) *reinterpret_cast<bf16x8*>(qrl + KRSWZ(r32, d0 * 2 + hi)) = *reinterpret_cast<const bf16x8*>(Qw + (4 + d0) * 16); }
    if constexpr (NQK == 12) { const bf16_t* Qw2 = Qrb + (long)(wid * 32 + r32) * LDQR + hi * 8;
#pragma unroll
      for (int d0 = 0; d0 < 4; ++d0) *reinterpret_cast<bf16x8*>(qrl + 4096 + KRSWZ(r32, d0 * 2 + hi)) = *reinterpret_cast<const bf16x8*>(Qw2 + d0 * 16); } }
  const int sr = tid >> 4, sc = (tid & 15) * 8, vst0 = v_st(sr, sc), vst1 = v_st(32 + sr, sc);
  const int krr = tid >> 3, krc = tid & 7;
  const int vb0 = (int)(uintptr_t)(LAS char*)V_lds + v_rd_base(lane);
  bf16x8 vs0, vs1, ks0, ks1, kr;
#define SLOAD1(k0) do { vs0 = *reinterpret_cast<const bf16x8*>(&Vh[(long)((k0) + sr) * LDKV + sc]); vs1 = *reinterpret_cast<const bf16x8*>(&Vh[(long)((k0) + 32 + sr) * LDKV + sc]); \
    ks0 = *reinterpret_cast<const bf16x8*>(&Kh[(long)((k0) + sr) * LDKV + sc]); ks1 = *reinterpret_cast<const bf16x8*>(&Kh[(long)((k0) + 32 + sr) * LDKV + sc]); \
    if constexpr (NQK == 12) kr = *reinterpret_cast<const bf16x8*>(&Krh[(long)((k0) + krr) * 64 + krc * 8]); } while (0)
#define SWRITE1(b) do { *(bf16x8*)(V_lds + (b) * SHM_V + vst0) = vs0; *(bf16x8*)(V_lds + (b) * SHM_V + vst1) = vs1; const int kc = sc * 2; \
    *(bf16x8*)(K_lds + (b) * SHM_K + KSWZ(sr, kc)) = ks0; *(bf16x8*)(K_lds + (b) * SHM_K + KSWZ(32 + sr, kc)) = ks1; \
    if constexpr (NQK == 12) *(bf16x8*)(KR_lds + (b) * SHM_KR + KRSWZ(krr, krc)) = kr; } while (0)
  f32x16 p0, p1; float mn, al; bf16x8 pa0, pa1, pa2, pa3; const int NT = seq / KVBLK;
  const int grp = wid >> 2;
  SLOAD1(0); SWRITE1(0); __syncthreads();
  if (1 < NT) SLOAD1(KVBLK);
  if (grp == 1) __syncthreads();
  for (int j = 0; j < NT; ++j) {
    const int b = j & 1;
    if (grp == 1 && j + 1 < NT) { SWRITE1(b ^ 1); if (j + 2 < NT) SLOAD1((j + 2) * KVBLK); }
    SBAR(); qkt<NQK, NREG>(p0, p1, K_lds + b * SHM_K, KR_lds + b * SHM_KR, qr, qrl, r32, hi);
    partialSM(p0, p1, m_reg, mn, al, C, thr_raw);
    if (__any(al < 1.f)) { if (hi == 0) al_l[r32] = al; asm volatile("s_waitcnt lgkmcnt(0)" ::: "memory");
#pragma unroll
      for (int d = 0; d < 4; ++d)
#pragma unroll
        for (int r = 0; r < 16; ++r) o[d][r] *= al_l[crow(r, hi)]; }
    finishSM(p0, p1, al, l_reg, pa0, pa1, pa2, pa3); SBAR();
    __syncthreads();
    pv_d0(o, vb0 + b * SHM_V, pa0, pa1, pa2, pa3);
    if (grp == 0 && j + 1 < NT) { SWRITE1(b ^ 1); if (j + 2 < NT) SLOAD1((j + 2) * KVBLK); }
    __syncthreads();
  }
  if (grp == 0) __syncthreads();
  if (hi == 0) li_l[r32] = l_reg; asm volatile("s_waitcnt lgkmcnt(0)" ::: "memory");
#pragma unroll
  for (int r = 0; r < 16; ++r) { const float rl = __builtin_amdgcn_rcpf(li_l[crow(r, hi)]);
#pragma unroll
    for (int d = 0; d < 4; ++d) o[d][r] *= rl; }
#undef SLOAD1
#undef SWRITE1
}
constexpr int R_V = 0, R_K = 3 * SHM_V, R_KR = R_K + 2 * SHM_K, R_WS = R_KR + 2 * SHM_KR, R_QR = R_WS + 8 * 64 * 4, LDS_ROT = R_QR + 8 * 4096;
template <int NQK, int LDQ, int LDQR>
__device__ __forceinline__ void attn_core_rot(f32x16 (&o)[4], const bf16_t* __restrict__ Qb, const bf16_t* __restrict__ Qrb, const bf16_t* __restrict__ Kh, const bf16_t* __restrict__ Krh,
                                              const bf16_t* __restrict__ Vh, const int seq, const float C, const float thr_raw, char* lds) {
  const int tid = threadIdx.x, wid = tid >> 6, lane = tid & 63, r32 = lane & 31, hi = lane >> 5, grp = wid >> 2;
  char* V_lds = lds + R_V; char* K_lds = lds + R_K; char* KR_lds = lds + R_KR;
  float* ws = (float*)(lds + R_WS) + wid * 64; float* li_l = ws; float* al_l = ws + 32;
  float m_reg = -1e30f, l_reg = 0;
#pragma unroll
  for (int d = 0; d < 4; ++d) o[d] = f32x16{};
  bf16x8 qr[8]; char* qrl = lds + R_QR + wid * 4096 - 4096;
  { const bf16_t* Qw = Qb + (long)(wid * 32 + r32) * LDQ + hi * 8;
#pragma unroll
    for (int d0 = 0; d0 < 8; ++d0) { qr[d0] = *reinterpret_cast<const bf16x8*>(Qw + d0 * 16); asm volatile("" : "+v"(qr[d0])); }
    if constexpr (NQK == 12) { const bf16_t* Qw2 = Qrb + (long)(wid * 32 + r32) * LDQR + hi * 8;
#pragma unroll
      for (int d0 = 0; d0 < 4; ++d0) *reinterpret_cast<bf16x8*>(qrl + 4096 + KRSWZ(r32, d0 * 2 + hi)) = *reinterpret_cast<const bf16x8*>(Qw2 + d0 * 16); } }
  const int sr = tid >> 4, sc = (tid & 15) * 8, vst0 = v_st(sr, sc), vst1 = v_st(32 + sr, sc);
  const int krr = tid >> 3, krc = tid & 7;
  const int vb0 = (int)(uintptr_t)(LAS char*)V_lds + v_rd_base(lane);
  bf16x8 vs0, vs1, ks0, ks1, kr;
#define SLOAD1(k0) do { vs0 = *reinterpret_cast<const bf16x8*>(&Vh[(long)((k0) + sr) * LDKV + sc]); vs1 = *reinterpret_cast<const bf16x8*>(&Vh[(long)((k0) + 32 + sr) * LDKV + sc]); \
    ks0 = *reinterpret_cast<const bf16x8*>(&Kh[(long)((k0) + sr) * LDKV + sc]); ks1 = *reinterpret_cast<const bf16x8*>(&Kh[(long)((k0) + 32 + sr) * LDKV + sc]); \
    if constexpr (NQK == 12) kr = *reinterpret_cast<const bf16x8*>(&Krh[(long)((k0) + krr) * 64 + krc * 8]); } while (0)
#define SWRITE1(b, vi) do { *(bf16x8*)(V_lds + (vi) * SHM_V + vst0) = vs0; *(bf16x8*)(V_lds + (vi) * SHM_V + vst1) = vs1; const int kc = sc * 2; \
    *(bf16x8*)(K_lds + (b) * SHM_K + KSWZ(sr, kc)) = ks0; *(bf16x8*)(K_lds + (b) * SHM_K + KSWZ(32 + sr, kc)) = ks1; \
    if constexpr (NQK == 12) *(bf16x8*)(KR_lds + (b) * SHM_KR + KRSWZ(krr, krc)) = kr; } while (0)
  f32x16 p0, p1; float mn, al; bf16x8 pa0, pa1, pa2, pa3; const int NT = seq / KVBLK;
  SLOAD1(0); SWRITE1(0, 0); __syncthreads();
  if (1 < NT) SLOAD1(KVBLK);
  int vprev = 2, vcur = 0, vnext = 1;
  for (int j = 0; j < NT; ++j) {
    const int b = j & 1;
    if (grp == 1 && j > 0) pv_d0(o, vb0 + vprev * SHM_V, pa0, pa1, pa2, pa3);
    SBAR(); qkt<NQK, 8>(p0, p1, K_lds + b * SHM_K, KR_lds + b * SHM_KR, qr, qrl, r32, hi);
    partialSM(p0, p1, m_reg, mn, al, C, thr_raw);
    if (__any(al < 1.f)) { if (hi == 0) al_l[r32] = al; asm volatile("s_waitcnt lgkmcnt(0)" ::: "memory");
#pragma unroll
      for (int d = 0; d < 4; ++d)
#pragma unroll
        for (int r = 0; r < 16; ++r) o[d][r] *= al_l[crow(r, hi)]; }
    finishSM(p0, p1, al, l_reg, pa0, pa1, pa2, pa3); SBAR();
    if (grp == 0) pv_d0(o, vb0 + vcur * SHM_V, pa0, pa1, pa2, pa3);
    if (j + 1 < NT) { SWRITE1(b ^ 1, vnext); if (j + 2 < NT) SLOAD1((j + 2) * KVBLK); }
    __syncthreads();
    vprev = vcur; vcur = vnext; vnext = (vnext == 2) ? 0 : vnext + 1;
  }
  if (grp == 1) pv_d0(o, vb0 + vprev * SHM_V, pa0, pa1, pa2, pa3);
  if (hi == 0) li_l[r32] = l_reg; asm volatile("s_waitcnt lgkmcnt(0)" ::: "memory");
#pragma unroll
  for (int r = 0; r < 16; ++r) { const float rl = __builtin_amdgcn_rcpf(li_l[crow(r, hi)]);
#pragma unroll
    for (int d = 0; d < 4; ++d) o[d][r] *= rl; }
  __syncthreads();
#undef SLOAD1
#undef SWRITE1
}
constexpr int PR_K = 0, PR_V = 2 * SHM_K, PR_P = PR_V + 3 * 2 * SHM_V, PR_MA = PR_P + 4 * 4096, LDS_PAIR = PR_MA + 2048 + 64;
__device__ __forceinline__ void attn_core_pair(f32x16 (&o)[4], const bf16_t* __restrict__ Qb, const bf16_t* __restrict__ Kh, const bf16_t* __restrict__ Vh, const int seq, const float C, const float thr_raw, char* lds) {
  const int tid = threadIdx.x, wid = tid >> 6, lane = tid & 63, r32 = lane & 31, hi = lane >> 5, rb = wid & 3, role = wid >> 2;
  char* K_lds = lds + PR_K; char* V_lds = lds + PR_V; char* P_l = lds + PR_P + rb * 4096 + lane * 16;
  float* ma = (float*)(lds + PR_MA); float* m_l = ma + rb * 32; float* l_l = ma + 128 + rb * 32; unsigned* fl_l = (unsigned*)(ma + 512);
#pragma unroll
  for (int d = 0; d < 4; ++d) o[d] = f32x16{};
  bf16x8 qr[8];
  { const bf16_t* Qw = Qb + (long)(rb * 32 + r32) * 1024 + hi * 8;
#pragma unroll
    for (int d0 = 0; d0 < 8; ++d0) { qr[d0] = *reinterpret_cast<const bf16x8*>(Qw + d0 * 16); asm volatile("" : "+v"(qr[d0])); } }
  const int sr = tid >> 4, sc = (tid & 15) * 8, vst0 = v_st(sr, sc), vst1 = v_st(32 + sr, sc);
  const int vb0 = (int)(uintptr_t)(LAS char*)V_lds + role * SHM_V + v_rd_base(lane);
  bf16x8 ks0, ks1, va0, va1, vb_0, vb_1;
#define PLOAD(k0) do { ks0 = *reinterpret_cast<const bf16x8*>(&Kh[(long)((k0) + sr) * LDKV + sc]); ks1 = *reinterpret_cast<const bf16x8*>(&Kh[(long)((k0) + 32 + sr) * LDKV + sc]); \
    va0 = *reinterpret_cast<const bf16x8*>(&Vh[(long)((k0) + sr) * LDKV + sc]); va1 = *reinterpret_cast<const bf16x8*>(&Vh[(long)((k0) + 32 + sr) * LDKV + sc]); \
    vb_0 = *reinterpret_cast<const bf16x8*>(&Vh[(long)((k0) + sr) * LDKV + 128 + sc]); vb_1 = *reinterpret_cast<const bf16x8*>(&Vh[(long)((k0) + 32 + sr) * LDKV + 128 + sc]); } while (0)
#define PWRITE(kb_, vi_) do { const int kc = sc * 2; *(bf16x8*)(K_lds + (kb_) * SHM_K + KSWZ(sr, kc)) = ks0; *(bf16x8*)(K_lds + (kb_) * SHM_K + KSWZ(32 + sr, kc)) = ks1; \
    char* vq = V_lds + (vi_) * (2 * SHM_V); *(bf16x8*)(vq + vst0) = va0; *(bf16x8*)(vq + vst1) = va1; *(bf16x8*)(vq + SHM_V + vst0) = vb_0; *(bf16x8*)(vq + SHM_V + vst1) = vb_1; } while (0)
  f32x16 p0, p1; bf16x8 pa0, pa1, pa2, pa3; const int NT = seq / KVBLK;
  PLOAD(0); PWRITE(0, 0); __syncthreads();
  if (1 < NT) PLOAD(KVBLK);
  int vprev = 2, vnext = 1;
  for (int j = 0; j <= NT; ++j) {
    const int kb = j & 1, par = j & 1;
    if (j >= 1) {
      const int pp = (j - 1) & 1;
      if (__builtin_amdgcn_readfirstlane(fl_l[pp * 4 + rb]) != 0u) {
        const float* al = ma + 256 + pp * 128 + rb * 32;
#pragma unroll
        for (int d = 0; d < 4; ++d)
#pragma unroll
          for (int r = 0; r < 16; ++r) o[d][r] *= al[crow(r, hi)]; }
      if (role != pp) { pa0 = *(const bf16x8*)(P_l); pa1 = *(const bf16x8*)(P_l + 1024); pa2 = *(const bf16x8*)(P_l + 2048); pa3 = *(const bf16x8*)(P_l + 3072); }
      pv_d0(o, vb0 + vprev * (2 * SHM_V), pa0, pa1, pa2, pa3);
    }
    if (j < NT && role == par) {
      float m_reg = (j == 0) ? -1e30f : m_l[r32], l_reg = (j == 0) ? 0.f : l_l[r32], mn, al;
      SBAR(); qkt<8, 8>(p0, p1, K_lds + kb * SHM_K, nullptr, qr, nullptr, r32, hi);
      partialSM(p0, p1, m_reg, mn, al, C, thr_raw);
      finishSM(p0, p1, al, l_reg, pa0, pa1, pa2, pa3); SBAR();
      *(bf16x8*)(P_l) = pa0; *(bf16x8*)(P_l + 1024) = pa1; *(bf16x8*)(P_l + 2048) = pa2; *(bf16x8*)(P_l + 3072) = pa3;
      const bool anyr = __any(al < 1.f);
      if (hi == 0) { m_l[r32] = m_reg; l_l[r32] = l_reg; ma[256 + par * 128 + rb * 32 + r32] = al; }
      if (lane == 0) fl_l[par * 4 + rb] = anyr ? 1u : 0u;
    }
    if (j + 1 < NT) { PWRITE(kb ^ 1, vnext); if (j + 2 < NT) PLOAD((j + 2) * KVBLK); }
    __syncthreads();
    vprev = (vprev == 2) ? 0 : vprev + 1; vnext = (vnext == 2) ? 0 : vnext + 1;
  }
#pragma unroll
  for (int r = 0; r < 16; ++r) { const float rl = __builtin_amdgcn_rcpf(l_l[crow(r, hi)]);
#pragma unroll
    for (int d = 0; d < 4; ++d) o[d][r] *= rl; }
  __syncthreads();
#undef PLOAD
#undef PWRITE
}
__device__ __forceinline__ void store_o_bf16(const f32x16 (&o)[4], bf16_t* Ob, int ldo) {
  const int tid = threadIdx.x, wid = tid >> 6, lane = tid & 63, r32 = lane & 31, hi = lane >> 5;
  bf16_t* Ow = Ob + (long)(wid * 32) * ldo + r32;
#pragma unroll
  for (int r = 0; r < 16; ++r) { const int orow = crow(r, hi);
#pragma unroll
    for (int d0 = 0; d0 < 4; ++d0) Ow[(long)orow * ldo + d0 * 32] = f2bf(o[d0][r]); }
}
__device__ __forceinline__ void store_o_bf16_lds(const f32x16 (&o)[4], bf16_t* Ob, int ldo, char* wl) {
  const int tid = threadIdx.x, wid = tid >> 6, lane = tid & 63, r32 = lane & 31, hi = lane >> 5;
  bf16_t* Ow = Ob + (long)(wid * 32 + (lane >> 3)) * ldo + (lane & 7) * 8;
#pragma unroll
  for (int h2 = 0; h2 < 2; ++h2) {
#pragma unroll
    for (int dd = 0; dd < 2; ++dd)
#pragma unroll
      for (int r = 0; r < 16; ++r) *(bf16_t*)(wl + crow(r, hi) * 128 + (dd * 32 + r32) * 2) = f2bf(o[h2 * 2 + dd][r]);
#pragma unroll
    for (int k = 0; k < 4; ++k) { const u32x4 v = *(const u32x4*)(wl + (k * 8 + (lane >> 3)) * 128 + (lane & 7) * 16); *(u32x4*)(Ow + (long)(k * 8) * ldo + h2 * 64) = v; }
  }
}
}

__device__ __forceinline__ float wave_sum(float v) {
#pragma unroll
  for (int o = 32; o >= 1; o >>= 1) v += __shfl_xor(v, o);
  return v;
}
enum { PM_ID = 0, PM_IN, PM_UQ, PM_GU };
__device__ __forceinline__ int perm_n0(int type, int p0, int& use1) {
  use1 = 0;
  if (type == PM_IN) {
    if (p0 < 768) return p0;
    if (p0 < 1024) { const int q = p0 - 768; return (q == 0) ? 768 : (q == 128 ? 800 : -1); }
    if (p0 < 3072) { const int tt = p0 - 1024, tile = tt >> 8, q = tt & 255, half = q >> 7, sub = (q >> 6) & 1, i = q & 63; return 832 + tile * 256 + sub * 128 + half * 64 + i; }
    return 2880 + (p0 - 3072);
  } else if (type == PM_UQ) {
    if (p0 < 1024) return (p0 >> 7) * 192 + (p0 & 127);
    const int tt = p0 - 1024, tile = tt >> 8, q = tt & 255, half = q >> 7, hh = (q >> 5) & 3; return (4 * tile + hh) * 192 + 128 + 32 * half;
  } else if (type == PM_GU) {
    const int tile = p0 >> 8, q = p0 & 255; if (q < 128) return tile * 128 + q; use1 = 1; return tile * 128 + q - 128;
  }
  return p0;
}
__device__ __forceinline__ void transpose_w(const float* __restrict__ src0, const float* __restrict__ src1, int K, int N, bf16_t* __restrict__ dst, int P, int type, float* tl, int first, int stride) {
  const int tid = threadIdx.x, nkt = K / 128, ntiles = nkt * (P / 64), c32 = tid & 31, kq = tid >> 5;
  for (int t = first; t < ntiles; t += stride) {
    const int pi = t / nkt, ki = t - pi * nkt, p0 = pi * 64, k0 = ki * 128;
    int u0, u1; const int n0a = perm_n0(type, p0, u0), n0b = perm_n0(type, p0 + 32, u1);
    const float* sa = (u0 ? src1 : src0) + (size_t)k0 * N + (n0a < 0 ? 0 : n0a) + c32; const float* sb = (u1 ? src1 : src0) + (size_t)k0 * N + (n0b < 0 ? 0 : n0b) + c32;
    float va[8], vb[8];
#pragma unroll
    for (int i = 0; i < 8; ++i) { va[i] = sa[(size_t)(kq + 16 * i) * N]; vb[i] = sb[(size_t)(kq + 16 * i) * N]; }
    __syncthreads();
#pragma unroll
    for (int i = 0; i < 8; ++i) { tl[(kq + 16 * i) * 33 + c32] = n0a < 0 ? 0.f : va[i]; tl[128 * 33 + (kq + 16 * i) * 33 + c32] = n0b < 0 ? 0.f : vb[i]; }
    __syncthreads();
    const int row = tid >> 4, kc = (tid & 15) * 8;
#pragma unroll
    for (int h = 0; h < 2; ++h) { const float* q = tl + h * 128 * 33 + kc * 33 + row;
      u32x4 w; w.x = cvt_pk_bf16(q[0], q[33]); w.y = cvt_pk_bf16(q[66], q[99]); w.z = cvt_pk_bf16(q[132], q[165]); w.w = cvt_pk_bf16(q[198], q[231]);
      *(u32x4*)(dst + (size_t)(p0 + h * 32 + row) * K + k0 + kc) = w; }
  }
}
__device__ __forceinline__ void rownorm_bf16(const float* __restrict__ x, const float* __restrict__ g, bf16_t* __restrict__ out, int nrows) {
  const int wave = threadIdx.x >> 6, lane = threadIdx.x & 63;
  for (int row = blockIdx.x * 8 + wave; row < nrows; row += gridDim.x * 8) {
    const f32x4* xr = (const f32x4*)(x + (size_t)row * DM); f32x4 v[8]; float ss = 0.f;
#pragma unroll
    for (int j = 0; j < 8; ++j) { v[j] = xr[lane + 64 * j]; ss += dot4(v[j]); }
    ss = wave_sum(ss); const float r = rsqrtf(ss * (1.f / DM) + NORM_EPS);
#pragma unroll
    for (int j = 0; j < 8; ++j) { const f32x4 gv = ((const f32x4*)g)[lane + 64 * j], w = v[j] * gv * r; u32x2 pk; pk.x = cvt_pk_bf16(w[0], w[1]); pk.y = cvt_pk_bf16(w[2], w[3]);
      *(u32x2*)(out + (size_t)row * DM + 4 * (lane + 64 * j)) = pk; }
  }
}

#define XB_TMO      128
#define XB_XCNT(j)  (256  + 64 * (j))
#define XB_XSUB(j)  (1280 + 64 * (j))
#define XB_XGEN(j)  (2304 + 64 * (j))
#define XB_TOP      3328
#define XB_TOPGEN   3392
#define XCD_BAR_WORDS 3456
#define XB_SPIN_CAP (1u << 18)

__device__ __forceinline__ unsigned xb_ld(unsigned* p)              { return __hip_atomic_load(p, __ATOMIC_RELAXED, __HIP_MEMORY_SCOPE_AGENT); }
__device__ __forceinline__ unsigned xb_add(unsigned* p, unsigned v) { return __hip_atomic_fetch_add(p, v, __ATOMIC_RELAXED, __HIP_MEMORY_SCOPE_AGENT); }
__device__ __forceinline__ unsigned xb_xcc_id() { return (unsigned)__builtin_amdgcn_s_getreg((3 << 11) | 20) & 0xFu; }
#define XB_SPIN(cond, bar) do { unsigned _sp = 0; while (cond) { __builtin_amdgcn_s_sleep(1); \
    if ((++_sp & 255u) == 0u) { if (xb_ld(&(bar)[XB_TMO])) break; if (_sp > XB_SPIN_CAP) { atomicAdd(&(bar)[XB_TMO], 1u); break; } } } } while (0)

struct XcdBarrier {
    unsigned* bar; unsigned x;
    volatile LAS unsigned* st;
};

__device__ __forceinline__ XcdBarrier xcd_barrier_post(unsigned* bar, volatile LAS unsigned* st) {
    XcdBarrier b; b.bar = bar; b.x = xb_xcc_id(); b.st = st;
    if (threadIdx.x == 0) (void)xb_add(&bar[XB_XCNT(b.x)], 1u);
    return b;
}
__device__ __forceinline__ void xcd_barrier_complete(unsigned* bar, unsigned x, unsigned& nloc, unsigned& nx) {
    const unsigned G = gridDim.x * gridDim.y * gridDim.z;
    unsigned sum, cnt, mine, sp = 0u;
    for (;;) {
        sum = 0u; cnt = 0u; mine = 0u;
#pragma unroll
        for (unsigned j = 0; j < 16; ++j) { const unsigned c = xb_ld(&bar[XB_XCNT(j)]); sum += c; cnt += (c > 0u) ? 1u : 0u; mine = (j == x) ? c : mine; }
        if (sum == G) break;
        __builtin_amdgcn_s_sleep(1);
        if ((++sp & 255u) == 0u) { if (xb_ld(&bar[XB_TMO])) break; if (sp > XB_SPIN_CAP) { atomicAdd(&bar[XB_TMO], 1u); break; } }
    }
    nloc = mine > 0u ? mine : 1u; nx = cnt > 0u ? cnt : 1u;
}

__device__ __forceinline__ void xcd_barrier(const XcdBarrier& b) {
    asm volatile("s_waitcnt vmcnt(0)" ::: "memory");
    __syncthreads();
    if (threadIdx.x == 0) {
        unsigned* bar = b.bar;
        __builtin_amdgcn_s_waitcnt(0);
        unsigned nloc = b.st[0], nx = b.st[1];
        if (nloc == 0u) { xcd_barrier_complete(bar, b.x, nloc, nx); b.st[0] = nloc; b.st[1] = nx; }
        const unsigned old = xb_add(&bar[XB_XSUB(b.x)], 1u);
        const unsigned gen = old / nloc;
        if (old + 1u == (gen + 1u) * nloc) {
            __builtin_amdgcn_fence(__ATOMIC_RELEASE, "agent");
            asm volatile("s_waitcnt vmcnt(0)" ::: "memory");
            const unsigned og = xb_add(&bar[XB_TOP], 1u);
            const unsigned tg = og / nx;
            if (og + 1u == (tg + 1u) * nx) xb_add(&bar[XB_TOPGEN], 1u);
            else XB_SPIN(xb_ld(&bar[XB_TOPGEN]) == tg, bar);
            __builtin_amdgcn_fence(__ATOMIC_ACQUIRE, "agent");
            xb_add(&bar[XB_XGEN(b.x)], 1u);
            asm volatile("s_waitcnt vmcnt(0)" ::: "memory");
        } else {
            XB_SPIN(xb_ld(&bar[XB_XGEN(b.x)]) == gen, bar);
            __builtin_amdgcn_fence(__ATOMIC_ACQUIRE, "agent");
            asm volatile("s_waitcnt vmcnt(0)" ::: "memory");
        }
    }
    __syncthreads();
}


constexpr int LDS_BYTES = at::LDS_PAIR;
static_assert(at::LDS_ATTN <= LDS_BYTES && at::LDS_ROT <= LDS_BYTES && pg8::STAGE_BYTES <= LDS_BYTES && LDS_BYTES % 16 == 0 && LDS_BYTES + 16 <= 163840, "LDS budget");
constexpr int LDS_TOTAL = LDS_BYTES + 16;
constexpr size_t O_CNT = O_SS + 344064 + 16384;
constexpr size_t O_BAR = O_SS + 344064;
static_assert(O_BAR + XCD_BAR_WORDS * 4 <= O_A && (size_t)(5 * T + 1) * 4 <= 344064, "barrier words fit");

__global__ void __launch_bounds__(512, 2) fwd_megakernel(const Params p) {
  extern __shared__ __attribute__((aligned(16))) unsigned char shm[];
  cg::grid_group grid = cg::this_grid();
  const int G = gridDim.x, bid = blockIdx.x, tid = threadIdx.x;
  unsigned char* ws = p.ws;
  float* ssb = (float*)(ws + O_SS);
  float* cos_d = (float*)(ws + O_COSD); float* sin_d = (float*)(ws + O_SIND); float* cos_r = (float*)(ws + O_COSR); float* sin_r = (float*)(ws + O_SINR);
  LAS unsigned char* lds = (LAS unsigned char*)shm;
  unsigned* barw = (unsigned*)(ws + O_BAR); volatile LAS unsigned* xst = (volatile LAS unsigned*)(lds + LDS_BYTES);
  if (tid < 4) xst[tid] = 0u;
  __syncthreads();
  (void)xcd_barrier_post(barw, xst);
  if (p.ph_lo < 0) grid.sync();
#ifndef PHMASK
#define PHMASK 0x7ff
#endif
#define IN(k) (((PHMASK >> (k)) & 1) && p.ph_lo <= (k) && (k) < p.ph_hi)
#ifndef DUPMASK
#define DUPMASK 0
#endif
#define SEAM(k) do { XcdBarrier xb_; xb_.bar = barw; xb_.x = xb_xcc_id(); xb_.st = xst; xcd_barrier(xb_); } while (0)
#define REP(k) for (int rep_ = 0; rep_ < 1 + ((DUPMASK >> (k)) & 1); ++rep_, ((DUPMASK >> (k)) & 1) ? grid.sync() : (void)0)

  if (IN(0)) REP(0) {
    float* tl = (float*)shm;
    transpose_w(p.in[I_WIN], nullptr, DM, IN_W, (bf16_t*)(ws + O_WIN), IN_P, PM_IN, tl, bid, G);
    transpose_w(p.in[I_WUQ], nullptr, 512, 1536, (bf16_t*)(ws + O_WUQ), 1536, PM_UQ, tl, bid, G);
    transpose_w(p.in[I_WUKV], nullptr, 256, 2048, (bf16_t*)(ws + O_WUKV), 2048, PM_ID, tl, bid, G);
    if (G != 256) transpose_w(p.in[I_WOUT], nullptr, DM, DM, (bf16_t*)(ws + O_WOUT), DM, PM_ID, tl, bid, G);
    if (G != 256) transpose_w(p.in[I_WXQ], nullptr, DM, 512, (bf16_t*)(ws + O_WXQ), 512, PM_ID, tl, bid, G);
    transpose_w(p.in[I_WXK], nullptr, DM, 512, (bf16_t*)(ws + O_WXKV), 512, PM_ID, tl, bid, G);
    transpose_w(p.in[I_WXV], nullptr, DM, 512, (bf16_t*)(ws + O_WXKV) + (size_t)512 * DM, 512, PM_ID, tl, bid, G);
    if (G != 256) transpose_w(p.in[I_WXO], nullptr, 512, DM, (bf16_t*)(ws + O_WXO), DM, PM_ID, tl, bid, G);
    transpose_w(p.in[I_WGATE], p.in[I_WUP], DM, FFN, (bf16_t*)(ws + O_WGU), 2 * FFN, PM_GU, tl, bid, G);
    if (G != 256) transpose_w(p.in[I_WDOWN], nullptr, FFN, DM, (bf16_t*)(ws + O_WDN), DM, PM_ID, tl, bid, G);
    rownorm_bf16(p.in[I_X], p.in[I_GMIX], (bf16_t*)(ws + O_H), T);
    rownorm_bf16(p.in[I_MEM], p.in[I_GMEM], (bf16_t*)(ws + O_HM), NB * MEMT);
    for (int i = bid * 512 + tid; i < 5 * T; i += G * 512) ssb[i] = 0.f;
    const int* pos = (const int*)p.in[I_POS];
    for (int i = bid * 512 + tid; i < T * 64; i += G * 512) { const int t = i >> 6, f = i & 63;
      const double rev = (double)pos[t] * INVF_D[f] * 0.15915494309189535; const float fr = (float)(rev - __builtin_rint(rev));
      cos_d[i] = __builtin_amdgcn_cosf(fr); sin_d[i] = __builtin_amdgcn_sinf(fr);
      if ((f & 1) == 0) { cos_r[t * 32 + (f >> 1)] = __builtin_amdgcn_cosf(fr); sin_r[t * 32 + (f >> 1)] = __builtin_amdgcn_sinf(fr); } }
    if (bid == 0 && tid < 64) {
      const float a = p.in[I_LQ1][tid] * p.in[I_LK1][tid] + p.in[I_LQ1][tid + 64] * p.in[I_LK1][tid + 64];
      const float b = p.in[I_LQ2][tid] * p.in[I_LK2][tid] + p.in[I_LQ2][tid + 64] * p.in[I_LK2][tid + 64];
      const float sa = wave_sum(a), sb = wave_sum(b);
      if (tid == 0) ssb[SS_LAM] = __expf(sa) - __expf(sb) + 0.2f;
    }
    __syncthreads();
  }
  SEAM(0);

  if (IN(1)) {
    pg8::Gemm g{(const bf16_t*)(ws + O_H), (const bf16_t*)(ws + O_WIN), T, IN_P, DM}; pg8::StaticOrder S; S.init(T, IN_P, G, bid);
    EpiProj E{(bf16_t*)(ws + O_CQ), (bf16_t*)(ws + O_CKV), (bf16_t*)(ws + O_KR), (bf16_t*)(ws + O_DQ), (bf16_t*)(ws + O_DK), (bf16_t*)(ws + O_DV), ssb + SS_CQ, ssb + SS_CKV,
              p.in[I_GQLAT], p.in[I_GKVLAT], cos_d, sin_d, cos_r, sin_r};
    pg8::gemm_phase(lds, g, S, E);
  }
  SEAM(1);

  if (IN(2)) {
#ifndef NO_Q
    { pg8::Gemm g{(const bf16_t*)(ws + O_CQ), (const bf16_t*)(ws + O_WUQ), T, 1536, 512}; pg8::StaticOrder S; S.init(T, 1536, G, bid);
      EpiQ E{(bf16_t*)(ws + O_QN), (bf16_t*)(ws + O_QR), ssb + SS_CQ, cos_r, sin_r};
      pg8::gemm_phase(lds, g, S, E); }
#endif
#ifndef NO_KV
    { pg8::Gemm g{(const bf16_t*)(ws + O_CKV), (const bf16_t*)(ws + O_WUKV), T, 2048, 256}; pg8::StaticOrder S; S.init(T, 2048, G, G - 1 - bid);
      EpiKV E{(bf16_t*)(ws + O_KN), (bf16_t*)(ws + O_VM), ssb + SS_CKV};
      pg8::gemm_phase(lds, g, S, E); }
#endif
    if (G == 256 && bid >= 128) {
      float* tl = (float*)shm;
      transpose_w(p.in[I_WOUT], nullptr, DM, DM, (bf16_t*)(ws + O_WOUT), DM, PM_ID, tl, bid - 128, 128);
      transpose_w(p.in[I_WXQ], nullptr, DM, 512, (bf16_t*)(ws + O_WXQ), 512, PM_ID, tl, bid - 128, 128); }
  }
  SEAM(2);

  if (IN(3)) {
    const int wid = tid >> 6, lane = tid & 63, r32 = lane & 31, hi = lane >> 5;
    const float LOG2E = 1.4426950408889634f;
#ifndef NO_DIFF
    for (int it = 0; bid + (it >> 2) * G < 256 * (1 + ((DUPMASK >> 3) & 1)); ++it) {
      const int pass = it & 3, hb = pass >> 1, u = (bid + (it >> 2) * G) & 255, x = u & 7, y = u >> 3, qb = y & 7, bh = (y >> 3) * 8 + x, b = bh >> 2, h = bh & 3;
      const size_t rowq = (size_t)b * SEQ + qb * 256, rowk = (size_t)b * SEQ;
      const int qsel = (pass & 1) ? 0 : 128;
      const bf16_t* dq = (const bf16_t*)(ws + O_DQ) + (rowq + hb * 128) * 1024 + h * 256 + qsel; const bf16_t* dk = (const bf16_t*)(ws + O_DK) + rowk * 1024 + h * 256 + qsel;
      const bf16_t* dv = (const bf16_t*)(ws + O_DV) + rowk * 1024 + h * 256;
      f32x4* sl = (f32x4*)(ws + O_SCR) + ((size_t)(u * 16 + (hb * 2 + (wid >> 2)) * 4 + (wid & 3)) * 1024 + lane);
      const float lam = ssb[SS_LAM]; const float C = 0.08838834764831845f * LOG2E, thr = 8.f / 0.08838834764831845f;
      f32x16 o[4];
      at::attn_core_pair(o, dq, dk, dv, SEQ, C, thr, (char*)shm);
#define O4(d, q) (f32x4){o[d][4 * (q)], o[d][4 * (q) + 1], o[d][4 * (q) + 2], o[d][4 * (q) + 3]}
      f32x4* sl8 = sl + 8 * 64;
      if ((pass & 1) == 0) {
#pragma unroll
        for (int d = 0; d < 4; ++d)
#pragma unroll
          for (int q = 0; q < 4; q += 2) sl8[(d * 2 + (q >> 1)) * 64] = __builtin_bit_cast(f32x4, pack8(O4(d, q), O4(d, q + 1)));
      } else {
#pragma unroll
        for (int d = 0; d < 4; ++d) {
#pragma unroll
          for (int q = 0; q < 4; q += 2) { const u32x4 w = __builtin_bit_cast(u32x4, sl8[(d * 2 + (q >> 1)) * 64]);
            const f32x4 a = {__uint_as_float(w.x << 16), __uint_as_float(w.x & 0xffff0000u), __uint_as_float(w.y << 16), __uint_as_float(w.y & 0xffff0000u)};
            const f32x4 b = {__uint_as_float(w.z << 16), __uint_as_float(w.z & 0xffff0000u), __uint_as_float(w.w << 16), __uint_as_float(w.w & 0xffff0000u)};
            sl[(d * 4 + q) * 64] = O4(d, q) - lam * a; sl[(d * 4 + q + 1) * 64] = O4(d, q + 1) - lam * b; }
          EPI_FENCE(); }
      }
#undef O4
    }
    __syncthreads();
    for (int u = bid; u < 256; u += G) {
      const int x = u & 7, y = u >> 3, qb = y & 7, bh = (y >> 3) * 8 + x, b = bh >> 2, h = bh & 3;
      const size_t rowq = (size_t)b * SEQ + qb * 256;
      const f32x4* scr = (const f32x4*)(ws + O_SCR) + ((size_t)(u * 16 + (wid >> 2) * 8 + (wid & 3)) * 1024 + lane);
      { float ssq[16];
#pragma unroll
        for (int r = 0; r < 16; ++r) ssq[r] = 0.f;
#pragma unroll 1
        for (int d = 0; d < 4; ++d) {
#pragma unroll
          for (int q = 0; q < 4; ++q) { const f32x4 lo = scr[(d * 4 + q) * 64], hv = scr[4 * 1024 + (d * 4 + q) * 64];
#pragma unroll
            for (int j = 0; j < 4; ++j) ssq[4 * q + j] += lo[j] * lo[j] + hv[j] * hv[j]; }
          EPI_FENCE(); }
#pragma unroll
        for (int r = 0; r < 16; ++r) {
#pragma unroll
          for (int s = 16; s >= 1; s >>= 1) ssq[r] += __shfl_xor(ssq[r], s);
          ssq[r] = rsqrtf(ssq[r] * (1.f / 256.f) + 1e-5f) * 0.8f; }
        const float* gd = p.in[I_GDIFF];
        char* wl = (char*)shm + wid * 16384;
#pragma unroll 1
        for (int d = 0; d < 4; ++d) { const float glo = gd[d * 32 + r32], ghi = gd[128 + d * 32 + r32];
#pragma unroll
          for (int q = 0; q < 4; ++q) { const f32x4 lo = scr[(d * 4 + q) * 64], hv = scr[4 * 1024 + (d * 4 + q) * 64];
#pragma unroll
            for (int j = 0; j < 4; ++j) { const int r = 4 * q + j; bf16_t* lp = (bf16_t*)(wl + (j + 8 * q + 4 * hi) * 512) + d * 32 + r32;
              lp[0] = f2bf(lo[j] * ssq[r] * glo); lp[128] = f2bf(hv[j] * ssq[r] * ghi); } }
          EPI_FENCE(); }
        bf16_t* Ow = (bf16_t*)(ws + O_ATT) + (rowq + wid * 32 + (lane >> 5)) * 2048 + 1024 + h * 256 + (lane & 31) * 8;
#pragma unroll
        for (int k = 0; k < 16; ++k) { const u32x4 v = *(const u32x4*)(wl + (k * 2 + (lane >> 5)) * 512 + (lane & 31) * 16); *(u32x4*)(Ow + (size_t)(k * 2) * 2048) = v; }
      }
    }
    __syncthreads();
#endif
#ifndef NO_MLA
    for (int uu = bid; uu < 512 * (1 + ((DUPMASK >> 3) & 1)); uu += G) {
      const int u = uu & 511, x = u & 7, y = u >> 3, qb = y & 7, bh = (y >> 3) * 8 + x, b = bh >> 3, h = bh & 7;
      const size_t rowq = (size_t)b * SEQ + qb * 256, rowk = (size_t)b * SEQ;
      const float sc = 0.07216878364870322f;
      f32x16 o[4];
      at::attn_core_rot<12, 1024, 512>(o, (const bf16_t*)(ws + O_QN) + rowq * 1024 + h * 128, (const bf16_t*)(ws + O_QR) + rowq * 512 + h * 64,
                                   (const bf16_t*)(ws + O_KN) + rowk * 1024 + h * 128, (const bf16_t*)(ws + O_KR) + rowk * 64, (const bf16_t*)(ws + O_VM) + rowk * 1024 + h * 128,
                                   SEQ, sc * LOG2E, 8.f / sc, (char*)shm);
      at::store_o_bf16_lds(o, (bf16_t*)(ws + O_ATT) + rowq * 2048 + h * 128, 2048, (char*)shm + at::R_QR + (tid >> 6) * 4096);
    }
#endif
  }
  SEAM(3);

  if (IN(4)) {
    pg8::Gemm g{(const bf16_t*)(ws + O_ATT), (const bf16_t*)(ws + O_WOUT), T, DM, DM}; pg8::StaticOrder S; S.init(T, DM, G, bid);
    EpiRes E{p.in[I_X], p.out, (bf16_t*)(ws + O_X1B), p.in[I_GXATTN], ssb + SS_X1};
    pg8::gemm_phase(lds, g, S, E);
  }
  SEAM(4);

  if (IN(5)) {
    { pg8::Gemm g{(const bf16_t*)(ws + O_X1B), (const bf16_t*)(ws + O_WXQ), T, 512, DM}; pg8::StaticOrder S; S.init(T, 512, G, bid);
      EpiScale E{(bf16_t*)(ws + O_XQ), 512, ssb + SS_X1, 1.f / 2048.f};
      pg8::gemm_phase(lds, g, S, E); }
    { pg8::Gemm g{(const bf16_t*)(ws + O_HM), (const bf16_t*)(ws + O_WXKV), NB * MEMT, 1024, DM}; pg8::StaticOrder S; S.init(NB * MEMT, 1024, G, G - 1 - bid);
      EpiScale E{(bf16_t*)(ws + O_XKV), 1024, nullptr, 0.f};
      pg8::gemm_phase(lds, g, S, E); }
    if (G == 256 && bid >= 128 && bid < 224) {
      float* tl = (float*)shm;
      transpose_w(p.in[I_WXO], nullptr, 512, DM, (bf16_t*)(ws + O_WXO), DM, PM_ID, tl, bid - 128, 96);
      transpose_w(p.in[I_WDOWN], nullptr, FFN, DM, (bf16_t*)(ws + O_WDN), DM, PM_ID, tl, bid - 128, 96); }
  }
  SEAM(5);

  if (IN(6)) {
    for (int u = bid; u < 256; u += G) {
      const int h = u & 3, rb = u >> 2, b = rb >> 3; const size_t rowq = (size_t)rb * 256, rowk = (size_t)b * MEMT;
      const float sc = 0.08838834764831845f; f32x16 o[4];
      at::attn_core<8, 512, 64, 2, 8>(o, (const bf16_t*)(ws + O_XQ) + rowq * 512 + h * 128, nullptr, (const bf16_t*)(ws + O_XKV) + rowk * 1024 + h * 128, nullptr,
                                (const bf16_t*)(ws + O_XKV) + rowk * 1024 + 512 + h * 128, MEMT, sc * 1.4426950408889634f, 8.f / sc, (char*)shm);
      at::store_o_bf16_lds(o, (bf16_t*)(ws + O_XO) + rowq * 512 + h * 128, 512, (char*)shm + at::OFF_QR + (tid >> 6) * 8192);
    }
  }
  SEAM(6);

  if (IN(7)) {
    pg8::Gemm g{(const bf16_t*)(ws + O_XO), (const bf16_t*)(ws + O_WXO), T, DM, 512}; pg8::StaticOrder S; S.init(T, DM, G, bid);
    EpiRes E{p.out, p.out, (bf16_t*)(ws + O_X2B), p.in[I_GFFN], ssb + SS_X2};
    pg8::gemm_phase(lds, g, S, E);
  }
  SEAM(7);

  if (IN(8)) REP(8) {
    pg8::Gemm g{(const bf16_t*)(ws + O_X2B), (const bf16_t*)(ws + O_WGU), T, 2 * FFN, DM}; pg8::StaticOrder S; S.init(T, 2 * FFN, G, bid);
    EpiSwiGLU E{(bf16_t*)(ws + O_HID), ssb + SS_X2};
    pg8::gemm_phase(lds, g, S, E);
  }
  SEAM(8);

  if (IN(9)) {
    pg8::Gemm g{(const bf16_t*)(ws + O_HID), (const bf16_t*)(ws + O_WDN), T, DM, FFN}; pg8::StaticOrder S; S.init(T, DM, G, bid);
    if (G == 256) { S.panel = 1; EpiFinal E{p.out, p.in[I_GFINAL], ssb + SS_X3, (unsigned*)(ws + O_CNT)};
      for (int rnd = 0; rnd < 2; ++rnd) { S.only = rnd; pg8::gemm_phase(lds, g, S, E); } }
    else { EpiRes E{p.out, p.out, nullptr, nullptr, ssb + SS_X3}; pg8::gemm_phase(lds, g, S, E); }
  }
  if (G != 256) {
    SEAM(9);
    const int wave = tid >> 6, lane = tid & 63; const float* gf = p.in[I_GFINAL];
    for (int row = bid * 8 + wave; row < T; row += G * 8) {
      const float r = rsqrtf(ssb[SS_X3 + row] * (1.f / DM) + NORM_EPS); f32x4* xr = (f32x4*)(p.out + (size_t)row * DM);
#pragma unroll
      for (int j = 0; j < 8; ++j) { const f32x4 gv = ((const f32x4*)gf)[lane + 64 * j]; xr[lane + 64 * j] = xr[lane + 64 * j] * gv * r; }
    }
  }
#undef IN
#undef SEAM
}

extern "C" void kernel_launch(void* const* d_in, const int* in_sizes, int n_in, void* d_out, int out_size, void* d_ws, size_t ws_size, hipStream_t stream) {
  static int grid_blocks = 0;
  if (grid_blocks == 0) {
    if (n_in != 26 || out_size != T * DM || ws_size < WS_END) { fprintf(stderr, "kernel_launch: unexpected shapes n_in %d out %d ws %zu (need %zu)\n", n_in, out_size, ws_size, (size_t)WS_END); grid_blocks = -1; return; }
    int dev = 0, cus = 0, per_cu = 0;
    hipGetDevice(&dev); hipDeviceGetAttribute(&cus, hipDeviceAttributeMultiprocessorCount, dev);
    if (hipFuncSetAttribute((const void*)fwd_megakernel, hipFuncAttributeMaxDynamicSharedMemorySize, LDS_TOTAL) != hipSuccess) { fprintf(stderr, "kernel_launch: hipFuncSetAttribute failed\n"); grid_blocks = -1; return; }
    if (hipOccupancyMaxActiveBlocksPerMultiprocessor(&per_cu, (const void*)fwd_megakernel, 512, LDS_TOTAL) != hipSuccess || per_cu < 1) { fprintf(stderr, "kernel_launch: occupancy query failed (%d)\n", per_cu); per_cu = 1; }
    (void)hipGetLastError();
    grid_blocks = cus * 1;
    fprintf(stderr, "kernel_launch: cus %d per_cu %d grid %d\n", cus, per_cu, grid_blocks);
  }
  if (grid_blocks < 0) return;
  if (hipMemsetAsync((char*)d_ws + O_BAR, 0, 32768, stream) != hipSuccess) { fprintf(stderr, "kernel_launch: hipMemsetAsync failed\n"); return; }
  Params p{};
  for (int i = 0; i < 26; ++i) p.in[i] = (const float*)d_in[i];
  p.out = (float*)d_out; p.ws = (unsigned char*)d_ws; p.ph_lo = 0; p.ph_hi = 11;
  void* args[] = {&p};
  hipError_t e = hipLaunchCooperativeKernel((const void*)fwd_megakernel, dim3(grid_blocks), dim3(512), args, LDS_TOTAL, stream);
  if (e != hipSuccess) fprintf(stderr, "kernel_launch: cooperative launch failed: %s (grid %d)\n", hipGetErrorString(e), grid_blocks);
}
```
